# Optimizing an MI355X kernel written in HIP

```python
import jax, jax.numpy as jnp
from jax import lax
import numpy as np

D_MODEL = 1024
BATCH = 8
SEQ = 2048
DEPTH = 1

CHUNK = 64
D_MIX = D_MODEL
A_WIDTH = 512
A_GROUPS = 4
A_GROUP_DIM = A_WIDTH // A_GROUPS
A_BLOCK = 128
B_HEADS = 8
B_HEAD_DIM = 64
B_WIDTH = B_HEADS * B_HEAD_DIM
B_KV_DIM = B_HEAD_DIM
IDX_HEADS = 8
IDX_DIM = 64
TOPK_MAX = 256
Q_BLOCK = 128
NORM_EPS = 1e-6
NEG = -1e30
IN_SIZES = (A_WIDTH, A_WIDTH, A_WIDTH,
            B_WIDTH, B_KV_DIM, B_KV_DIM, B_WIDTH,
            IDX_HEADS * IDX_DIM, IDX_DIM, IDX_HEADS)
D_IN = 3272

kernel_name = "hybrid_sgu_dsa_chunk_causal_block"


def rmsnorm(x, g):
    x32 = x.astype(jnp.float32)
    y = x32 * lax.rsqrt(jnp.mean(x32 * x32, axis=-1, keepdims=True) + NORM_EPS)
    return (y * g.astype(jnp.float32)).astype(x.dtype)


def layernorm(x, g):
    x32 = x.astype(jnp.float32)
    mu = jnp.mean(x32, axis=-1, keepdims=True)
    var = jnp.mean(jnp.square(x32 - mu), axis=-1, keepdims=True)
    y = (x32 - mu) * lax.rsqrt(var + NORM_EPS)
    return (y * g.astype(jnp.float32)).astype(x.dtype)


def split_cols(h, sizes):
    outs, off = [], 0
    for s in sizes:
        outs.append(h[..., off:off + s])
        off += s
    return outs


def spatial_gating(u, v, v_gain, w_s, b_s):
    bsz, seq, _ = u.shape
    nb = seq // A_BLOCK
    u = jax.nn.gelu(u)
    v = jax.nn.gelu(v).reshape(bsz, nb, A_BLOCK, A_GROUPS, A_GROUP_DIM)
    v = layernorm(v, v_gain.reshape(A_GROUPS, A_GROUP_DIM))
    pos = jnp.arange(A_BLOCK)
    mask = (pos[None, :] // CHUNK) <= (pos[:, None] // CHUNK)
    w = jnp.where(mask[None], w_s, jnp.zeros_like(w_s))
    s = jnp.einsum('gij,bnjgc->bnigc', w, v) + b_s.T[None, None, :, :, None]
    return u * s.reshape(bsz, seq, A_WIDTH)


def sparse_attention(q, k, v, qi, ki, wi):
    bsz, seq = q.shape[:2]
    topk = min(TOPK_MAX, seq // 4)
    nb = seq // Q_BLOCK
    key_chunk = jnp.arange(seq) // CHUNK
    slopes = 2.0 ** (-8.0 * jnp.arange(1, B_HEADS + 1, dtype=jnp.float32) / B_HEADS)
    scale = B_HEAD_DIM ** -0.5
    ki32 = ki.astype(jnp.float32)
    gather = jax.vmap(lambda a, i: a[i])

    def to_blocks(a):
        return a.reshape(bsz, nb, Q_BLOCK, *a.shape[2:]).swapaxes(0, 1)

    def block(args):
        qb, qib, wib, qpos = args
        logits = jnp.einsum('bqhd,bsd->bqhs', qib.astype(jnp.float32), ki32)
        idx_score = jnp.einsum('bqhs,bqh->bqs', jax.nn.relu(logits), wib.astype(jnp.float32))
        qchunk = qpos // CHUNK
        admissible = key_chunk[None, :] <= qchunk[:, None]
        idx_score = jnp.where(admissible[None], idx_score, NEG)
        _, sel = lax.top_k(idx_score, topk)
        valid = (sel // CHUNK) <= qchunk[None, :, None]
        k_sel = gather(k, sel)
        v_sel = gather(v, sel)
        scores = jnp.einsum('bqhd,bqkd->bhqk', qb, k_sel).astype(jnp.float32) * scale
        dist = jnp.abs(qpos[None, :, None] - sel).astype(jnp.float32)
        scores = scores - slopes[None, :, None, None] * dist[:, None]
        scores = jnp.where(valid[:, None], scores, NEG)
        p = jax.nn.softmax(scores, axis=-1).astype(v.dtype)
        return jnp.einsum('bhqk,bqkd->bqhd', p, v_sel)

    qpos_blocks = jnp.arange(seq).reshape(nb, Q_BLOCK)
    out = lax.map(block, (to_blocks(q), to_blocks(qi), to_blocks(wi), qpos_blocks))
    return out.swapaxes(0, 1).reshape(bsz, seq, B_HEADS * B_KV_DIM)


def setup_inputs(seed: int = 0) -> dict:
    key = jax.random.key(seed)
    ks = jax.random.split(key, 11)
    f32 = jnp.float32
    return {
        "x": jax.random.normal(ks[0], (BATCH, SEQ, D_MODEL), f32),
        "norm_gain": 1.0 + 0.02 * jax.random.normal(ks[1], (DEPTH, D_MODEL), f32),
        "w_in": jax.random.normal(ks[2], (DEPTH, D_MODEL, D_IN), f32) * D_MODEL ** -0.5,
        "sgu_norm_gain": 1.0 + 0.02 * jax.random.normal(ks[3], (DEPTH, A_WIDTH), f32),
        "sgu_w": jax.random.normal(ks[4], (DEPTH, A_GROUPS, A_BLOCK, A_BLOCK), f32) * A_BLOCK ** -0.5,
        "sgu_b": 1.0 + 0.1 * jax.random.normal(ks[5], (DEPTH, A_GROUPS, A_BLOCK), f32),
        "q_norm_gain": 1.0 + 0.02 * jax.random.normal(ks[6], (DEPTH, B_HEAD_DIM), f32),
        "k_norm_gain": 1.0 + 0.02 * jax.random.normal(ks[7], (DEPTH, B_HEAD_DIM), f32),
        "idx_k_norm_gain": 1.0 + 0.02 * jax.random.normal(ks[8], (DEPTH, IDX_DIM), f32),
        "branch_norm_gain": 1.0 + 0.02 * jax.random.normal(ks[9], (DEPTH, D_MIX), f32),
        "w_out": jax.random.normal(ks[10], (DEPTH, D_MIX, D_MODEL), f32) * D_MIX ** -0.5,
    }


def reference(x, norm_gain, w_in, sgu_norm_gain, sgu_w, sgu_b, q_norm_gain, k_norm_gain,
              idx_k_norm_gain, branch_norm_gain, w_out):
    bsz, seq, _ = x.shape
    idx_w_scale = (IDX_HEADS ** -0.5) * (IDX_DIM ** -0.5)
    for l in range(DEPTH):
        h = rmsnorm(x, norm_gain[l])
        proj = jnp.einsum('bsd,de->bse', h, w_in[l])
        a_u, a_v, a_z, b_q, b_k, b_v, b_z, i_q, i_k, i_w = split_cols(proj, IN_SIZES)
        ya = spatial_gating(a_u, a_v, sgu_norm_gain[l], sgu_w[l], sgu_b[l])
        q = rmsnorm(b_q.reshape(bsz, seq, B_HEADS, B_HEAD_DIM), q_norm_gain[l])
        k = rmsnorm(b_k, k_norm_gain[l])
        qi = i_q.reshape(bsz, seq, IDX_HEADS, IDX_DIM)
        ki = layernorm(i_k, idx_k_norm_gain[l])
        wi = i_w * idx_w_scale
        yb = sparse_attention(q, k, b_v, qi, ki, wi)
        ga = branch_norm_gain[l, :A_WIDTH].reshape(A_GROUPS, A_GROUP_DIM)
        gb = branch_norm_gain[l, A_WIDTH:].reshape(B_HEADS, B_KV_DIM)
        oa = rmsnorm(ya.reshape(bsz, seq, A_GROUPS, A_GROUP_DIM), ga).reshape(bsz, seq, A_WIDTH)
        ob = rmsnorm(yb.reshape(bsz, seq, B_HEADS, B_KV_DIM), gb).reshape(bsz, seq, B_WIDTH)
        mixed = jnp.concatenate([oa * jax.nn.silu(a_z), ob * jax.nn.silu(b_z)], axis=-1)
        x = x + jnp.einsum('bse,ed->bsd', mixed, w_out[l])
    return x
```

```cpp
#include <hip/hip_runtime.h>
#include <hip/hip_cooperative_groups.h>
#include <stdint.h>
#include <cstdio>
namespace cg = cooperative_groups;

typedef unsigned short bf16_t;
typedef short bf16x8 __attribute__((ext_vector_type(8)));
typedef float f32x4 __attribute__((ext_vector_type(4)));
typedef float f32x16 __attribute__((ext_vector_type(16)));
typedef unsigned u32x4 __attribute__((ext_vector_type(4)));
typedef unsigned u32x2 __attribute__((ext_vector_type(2)));

#define T_TOK 16384
#define SEQ 2048
#define NB 8
#define DM 1024
#define DIN 3272
#define EPS 1e-6f

__device__ __forceinline__ float bf2f(bf16_t v) { return __uint_as_float(((unsigned)v) << 16); }
__device__ __forceinline__ bf16_t f2bf(float f) {
    unsigned u = __float_as_uint(f);
    u += 0x7fffu + ((u >> 16) & 1u);
    return (bf16_t)(u >> 16);
}
__device__ __forceinline__ float gelu_tanh(float x) {
    const float t = x * x * 0.044715f + 1.0f;
    const float e = __builtin_amdgcn_exp2f(x * t * (-2.0f * 0.7978845608028654f * 1.4426950408889634f));
    return x * __builtin_amdgcn_rcpf(1.0f + e);
}
__device__ __forceinline__ float silu_f(float x) { return x * __builtin_amdgcn_rcpf(1.0f + __builtin_amdgcn_exp2f(x * -1.4426950408889634f)); }
__device__ __forceinline__ float wave_sum(float v) {
#pragma unroll
    for (int o = 32; o >= 1; o >>= 1) v += __shfl_xor(v, o);
    return v;
}
__device__ __forceinline__ int perm16(int k) { return k < 4 ? k : (k < 8 ? k + 4 : (k < 12 ? k - 4 : k)); }
__device__ __forceinline__ int vt_pos(int s) { return (s & ~15) | perm16(s & 15); }

struct WS {
    bf16_t* qn;
    bf16_t* qi;
    bf16_t* gz;
    bf16_t* mixed;
    bf16_t* kn;
    bf16_t* kin;
    bf16_t* vt;
    float* wi;
    float* rinv;
    bf16_t* xb;
    bf16_t* WinT;
    bf16_t* WoutT;
    bf16_t* Wm;
    bf16_t* gu;
    bf16_t* vn;
    bf16_t* gza;
    unsigned* bar;
};
static WS make_ws(void* d_ws) {
    char* p = (char*)d_ws; WS w;
    auto take = [&](size_t bytes) { char* r = p; p += (bytes + 255) & ~(size_t)255; return r; };
    w.qn = (bf16_t*)take((size_t)T_TOK * 512 * 2);
    w.qi = (bf16_t*)take((size_t)T_TOK * 512 * 2);
    w.gz = (bf16_t*)take((size_t)T_TOK * 512 * 2);
    w.mixed = (bf16_t*)take((size_t)T_TOK * 1024 * 2);
    w.kn = (bf16_t*)take((size_t)T_TOK * 64 * 2);
    w.kin = (bf16_t*)take((size_t)T_TOK * 64 * 2);
    w.vt = (bf16_t*)take((size_t)T_TOK * 64 * 2);
    w.wi = (float*)take((size_t)T_TOK * 8 * 4);
    w.rinv = (float*)take((size_t)T_TOK * 4);
    w.xb = (bf16_t*)take((size_t)T_TOK * 1024 * 2);
    w.WinT = (bf16_t*)take((size_t)3328 * 1024 * 2);
    w.WoutT = (bf16_t*)take((size_t)1024 * 1024 * 2);
    w.Wm = (bf16_t*)take((size_t)4 * 128 * 128 * 2);
    w.gu = (bf16_t*)take((size_t)T_TOK * 512 * 2);
    w.vn = (bf16_t*)take((size_t)T_TOK * 512 * 2);
    w.gza = (bf16_t*)take((size_t)T_TOK * 512 * 2);
    w.bar = (unsigned*)take((size_t)4096 * 4);
    return w;
}

#define LAS __attribute__((address_space(3)))
#define NT 512
#define LROW 72
#define RING_STAGE 49152
#define RING_BYTES (3 * RING_STAGE)
#define ST_OFF RING_BYTES
#define SMEM_BYTES (RING_BYTES + 4096)

struct Params {
    const float* x; const float* norm_gain; const float* w_in; const float* sgu_ng; const float* sgu_w; const float* sgu_b;
    const float* qg; const float* kg; const float* ikg; const float* bng; const float* w_out; float* out;
    WS w;
};

typedef float f32x2 __attribute__((ext_vector_type(2)));
typedef __bf16 hbf16x2 __attribute__((ext_vector_type(2)));
__device__ __forceinline__ unsigned pack_bf2(float lo, float hi) {
    const f32x2 v = {lo, hi};
    return __builtin_bit_cast(unsigned, __builtin_convertvector(v, hbf16x2));
}
__device__ __forceinline__ float bf_lo(unsigned u) { return __uint_as_float(u << 16); }
__device__ __forceinline__ float bf_hi(unsigned u) { return __uint_as_float(u & 0xffff0000u); }

__device__ __forceinline__ int opaque_grid() { int g = (int)gridDim.x; asm volatile("" : "+s"(g)); return g; }
#define GWAIT_V(n) asm volatile("s_waitcnt vmcnt(" #n ")" ::: "memory")
#define GBAR() do { __builtin_amdgcn_s_barrier(); asm volatile("" ::: "memory"); } while (0)
__device__ __forceinline__ void gemm_ring(const bf16_t* __restrict__ Wt, const bf16_t* __restrict__ Xt, char* smem, f32x4 (&acc)[4][4], int tid,
                                          int st0 = 0, int pre = 0, const bf16_t* __restrict__ nWt = nullptr, const bf16_t* __restrict__ nXt = nullptr) {
    const int wv = __builtin_amdgcn_readfirstlane(tid >> 6), lane = tid & 63, wm = wv >> 2, wn = wv & 3, fr = lane & 15, fq = lane >> 4;
    LAS char* lds = (LAS char*)smem;
    const int sc = (lane & 7) ^ ((((wv & 1) << 2) + (lane >> 4)) & 7);
    const bf16_t* gX = Xt + (size_t)(wv * 8 + (lane >> 3)) * DM + sc * 8;
    const bf16_t* gW = Wt + (size_t)(wv * 8 + (lane >> 3)) * DM + sc * 8;
    const bool has_next = nWt != nullptr;
    const bf16_t* gX2 = (has_next ? nXt : Xt) + (size_t)(wv * 8 + (lane >> 3)) * DM + sc * 8;
    const bf16_t* gW2 = (has_next ? nWt : Wt) + (size_t)(wv * 8 + (lane >> 3)) * DM + sc * 8;
#define GSTAGE_N(st, k0) do { LAS char* _b = lds + (st) * RING_STAGE + wv * 1024; \
        _Pragma("unroll") for (int _i = 0; _i < 4; ++_i) __builtin_amdgcn_global_load_lds((const unsigned*)(gX2 + (size_t)_i * 64 * DM + (k0)), (LAS unsigned*)(_b + _i * 8192), 16, 0, 0); \
        _Pragma("unroll") for (int _i = 0; _i < 2; ++_i) __builtin_amdgcn_global_load_lds((const unsigned*)(gW2 + (size_t)_i * 64 * DM + (k0)), (LAS unsigned*)(_b + 32768 + _i * 8192), 16, 0, 0); } while (0)
#define GSTAGE(st, k0) do { LAS char* _b = lds + (st) * RING_STAGE + wv * 1024; \
        _Pragma("unroll") for (int _i = 0; _i < 4; ++_i) __builtin_amdgcn_global_load_lds((const unsigned*)(gX + (size_t)_i * 64 * DM + (k0)), (LAS unsigned*)(_b + _i * 8192), 16, 0, 0); \
        _Pragma("unroll") for (int _i = 0; _i < 2; ++_i) __builtin_amdgcn_global_load_lds((const unsigned*)(gW + (size_t)_i * 64 * DM + (k0)), (LAS unsigned*)(_b + 32768 + _i * 8192), 16, 0, 0); } while (0)
    const int sl0 = ((fq) ^ (fr >> 1)) << 4, sl1 = ((4 + fq) ^ (fr >> 1)) << 4;
    const int offX = wn * 8192 + fr * 128, offW = 32768 + wm * 8192 + fr * 128;
#pragma unroll
    for (int mi = 0; mi < 4; ++mi)
#pragma unroll
        for (int ni = 0; ni < 4; ++ni) acc[mi][ni] = (f32x4){0.f, 0.f, 0.f, 0.f};
    const int s1 = (st0 == 2) ? 0 : st0 + 1, s2 = (s1 == 2) ? 0 : s1 + 1;
    GWAIT_V(0);
    GBAR();
    if (pre == 0) GSTAGE(st0, 0);
    if (pre != 1) GSTAGE(s1, 64);
    GSTAGE(s2, 128);
    bf16x8 A0[4], B0[4], A1[4], B1[4];
#define GLDFRAG(A_, B_, sb_, sl_) do { _Pragma("unroll") for (int _i = 0; _i < 4; ++_i) { \
        A_[_i] = *(const LAS bf16x8*)((sb_) + offW + _i * 2048 + (sl_)); B_[_i] = *(const LAS bf16x8*)((sb_) + offX + _i * 2048 + (sl_)); } } while (0)
#define GMMA(A_, B_) do { _Pragma("unroll") for (int _m = 0; _m < 4; ++_m) _Pragma("unroll") for (int _n = 0; _n < 4; ++_n) \
        acc[_m][_n] = __builtin_amdgcn_mfma_f32_16x16x32_bf16(A_[_m], B_[_n], acc[_m][_n], 0, 0, 0); } while (0)
#define GMMA_ROW(A_, B_, m_) do { __builtin_amdgcn_s_setprio(1); _Pragma("unroll") for (int _n = 0; _n < 4; ++_n) \
        acc[m_][_n] = __builtin_amdgcn_mfma_f32_16x16x32_bf16(A_[m_], B_[_n], acc[m_][_n], 0, 0, 0); __builtin_amdgcn_s_setprio(0); } while (0)
    if (pre == 0) { GWAIT_V(12); GBAR(); }
    GLDFRAG(A0, B0, lds + st0 * RING_STAGE, sl0);
    int st = st0;
    for (int kt = 0; kt < 16; ++kt) {
        const LAS char* sb = lds + st * RING_STAGE;
        const int sn = (st == 2) ? 0 : st + 1;
        GMMA_ROW(A0, B0, 0);
        __builtin_amdgcn_sched_barrier(0);
        GLDFRAG(A1, B1, sb, sl1);
        __builtin_amdgcn_sched_barrier(0);
        GMMA_ROW(A0, B0, 1); GMMA_ROW(A0, B0, 2); GMMA_ROW(A0, B0, 3);
        __builtin_amdgcn_sched_barrier(0);
        if (kt < 15) {
            if (kt < 14 || has_next) GWAIT_V(6); else GWAIT_V(0);
            asm volatile("s_waitcnt lgkmcnt(0)" ::: "memory");
            GBAR();
            if (wv < 4) {
                if (kt + 3 < 16) GSTAGE(st, (kt + 3) * 64);
                else if (has_next) GSTAGE_N(st, (kt - 13) * 64);
            }
        }
        GMMA_ROW(A1, B1, 0);
        __builtin_amdgcn_sched_barrier(0);
        if (kt < 15) GLDFRAG(A0, B0, lds + sn * RING_STAGE, sl0);
        __builtin_amdgcn_sched_barrier(0);
        GMMA_ROW(A1, B1, 1); GMMA_ROW(A1, B1, 2); GMMA_ROW(A1, B1, 3);
        __builtin_amdgcn_sched_barrier(0);
        if (wv >= 4 && kt < 15) {
            if (kt + 3 < 16) GSTAGE(st, (kt + 3) * 64);
            else if (has_next) GSTAGE_N(st, (kt - 13) * 64);
        }
        __builtin_amdgcn_sched_barrier(0);
        st = sn;
    }
#undef GMMA_ROW
#undef GLDFRAG
#undef GMMA
#undef GSTAGE
#undef GSTAGE_N
}

#define R2_STAGE 65536
__device__ __forceinline__ void gemm_ring256(const bf16_t* __restrict__ Wt, const bf16_t* __restrict__ Xt, char* smem, f32x4 (&acc)[8][4], int tid, bool pre = false) {
    const int wv = __builtin_amdgcn_readfirstlane(tid >> 6), lane = tid & 63, wm = wv >> 2, wn = wv & 3, fr = lane & 15, fq = lane >> 4;
    LAS char* lds = (LAS char*)smem;
    const int sc = (lane & 7) ^ ((((wv & 1) << 2) + (lane >> 4)) & 7);
    const bf16_t* gX = Xt + (size_t)(wv * 8 + (lane >> 3)) * DM + sc * 8;
    const bf16_t* gW = Wt + (size_t)(wv * 8 + (lane >> 3)) * DM + sc * 8;
#define G2STAGE(st, k0) do { LAS char* _b = lds + (st) * R2_STAGE + wv * 1024; \
        _Pragma("unroll") for (int _i = 0; _i < 4; ++_i) __builtin_amdgcn_global_load_lds((const unsigned*)(gX + (size_t)_i * 64 * DM + (k0)), (LAS unsigned*)(_b + _i * 8192), 16, 0, 0); \
        _Pragma("unroll") for (int _i = 0; _i < 4; ++_i) __builtin_amdgcn_global_load_lds((const unsigned*)(gW + (size_t)_i * 64 * DM + (k0)), (LAS unsigned*)(_b + 32768 + _i * 8192), 16, 0, 0); } while (0)
    const int sl0 = ((fq) ^ (fr >> 1)) << 4, sl1 = ((4 + fq) ^ (fr >> 1)) << 4;
    const int offX = wn * 8192 + fr * 128, offW = 32768 + wm * 16384 + fr * 128;
#pragma unroll
    for (int mi = 0; mi < 8; ++mi)
#pragma unroll
        for (int ni = 0; ni < 4; ++ni) acc[mi][ni] = (f32x4){0.f, 0.f, 0.f, 0.f};
    GWAIT_V(0);
    GBAR();
    if (!pre) G2STAGE(0, 0);
    G2STAGE(1, 64);
    bf16x8 A0[8], B0[4], A1[8], B1[4];
#define G2LDFRAG(A_, B_, sb_, sl_) do { _Pragma("unroll") for (int _i = 0; _i < 8; ++_i) A_[_i] = *(const LAS bf16x8*)((sb_) + offW + _i * 2048 + (sl_)); \
        _Pragma("unroll") for (int _i = 0; _i < 4; ++_i) B_[_i] = *(const LAS bf16x8*)((sb_) + offX + _i * 2048 + (sl_)); } while (0)
#define G2MMA_ROW(A_, B_, m_) do { __builtin_amdgcn_s_setprio(1); _Pragma("unroll") for (int _n = 0; _n < 4; ++_n) \
        acc[m_][_n] = __builtin_amdgcn_mfma_f32_16x16x32_bf16(A_[m_], B_[_n], acc[m_][_n], 0, 0, 0); __builtin_amdgcn_s_setprio(0); } while (0)
    if (!pre) { GWAIT_V(8); GBAR(); }
    G2LDFRAG(A0, B0, lds, sl0);
    for (int kt = 0; kt < 16; ++kt) {
        const int s = kt & 1;
        const LAS char* sb = lds + s * R2_STAGE;
        G2MMA_ROW(A0, B0, 0);
        __builtin_amdgcn_sched_barrier(0);
        G2LDFRAG(A1, B1, sb, sl1);
        __builtin_amdgcn_sched_barrier(0);
        G2MMA_ROW(A0, B0, 1); G2MMA_ROW(A0, B0, 2); G2MMA_ROW(A0, B0, 3); G2MMA_ROW(A0, B0, 4); G2MMA_ROW(A0, B0, 5); G2MMA_ROW(A0, B0, 6); G2MMA_ROW(A0, B0, 7);
        __builtin_amdgcn_sched_barrier(0);
        if (kt < 15) {
            GWAIT_V(0);
            asm volatile("s_waitcnt lgkmcnt(0)" ::: "memory");
            GBAR();
            if (kt + 2 < 16 && wv < 4) G2STAGE(s, (kt + 2) * 64);
        }
        G2MMA_ROW(A1, B1, 0);
        __builtin_amdgcn_sched_barrier(0);
        if (kt < 15) G2LDFRAG(A0, B0, lds + (s ^ 1) * R2_STAGE, sl0);
        __builtin_amdgcn_sched_barrier(0);
        G2MMA_ROW(A1, B1, 1); G2MMA_ROW(A1, B1, 2); G2MMA_ROW(A1, B1, 3); G2MMA_ROW(A1, B1, 4); G2MMA_ROW(A1, B1, 5); G2MMA_ROW(A1, B1, 6); G2MMA_ROW(A1, B1, 7);
        __builtin_amdgcn_sched_barrier(0);
        if (kt + 2 < 16 && wv >= 4) G2STAGE(s, (kt + 2) * 64);
        __builtin_amdgcn_sched_barrier(0);
    }
#undef G2MMA_ROW
#undef G2LDFRAG
#undef G2STAGE
}

__device__ __forceinline__ void g2_prefetch0(const bf16_t* __restrict__ Wt, const bf16_t* __restrict__ Xt, char* smem, int tid) {
    const int wv = __builtin_amdgcn_readfirstlane(tid >> 6), lane = tid & 63;
    LAS char* lds = (LAS char*)smem;
    const int sc = (lane & 7) ^ ((((wv & 1) << 2) + (lane >> 4)) & 7);
    const bf16_t* gX = Xt + (size_t)(wv * 8 + (lane >> 3)) * DM + sc * 8;
    const bf16_t* gW = Wt + (size_t)(wv * 8 + (lane >> 3)) * DM + sc * 8;
    LAS char* b = lds + wv * 1024;
#pragma unroll
    for (int i = 0; i < 4; ++i) __builtin_amdgcn_global_load_lds((const unsigned*)(gX + (size_t)i * 64 * DM), (LAS unsigned*)(b + i * 8192), 16, 0, 0);
#pragma unroll
    for (int i = 0; i < 4; ++i) __builtin_amdgcn_global_load_lds((const unsigned*)(gW + (size_t)i * 64 * DM), (LAS unsigned*)(b + 32768 + i * 8192), 16, 0, 0);
}

__device__ __forceinline__ void g1_prefetch0(const bf16_t* __restrict__ Wt, const bf16_t* __restrict__ Xt, char* smem, int tid) {
    const int wv = __builtin_amdgcn_readfirstlane(tid >> 6), lane = tid & 63;
    LAS char* lds = (LAS char*)smem;
    const int sc = (lane & 7) ^ ((((wv & 1) << 2) + (lane >> 4)) & 7);
    const bf16_t* gX = Xt + (size_t)(wv * 8 + (lane >> 3)) * DM + sc * 8;
    const bf16_t* gW = Wt + (size_t)(wv * 8 + (lane >> 3)) * DM + sc * 8;
    LAS char* b = lds + wv * 1024;
#pragma unroll
    for (int i = 0; i < 4; ++i) __builtin_amdgcn_global_load_lds((const unsigned*)(gX + (size_t)i * 64 * DM), (LAS unsigned*)(b + i * 8192), 16, 0, 0);
#pragma unroll
    for (int i = 0; i < 2; ++i) __builtin_amdgcn_global_load_lds((const unsigned*)(gW + (size_t)i * 64 * DM), (LAS unsigned*)(b + 32768 + i * 8192), 16, 0, 0);
}

__device__ __forceinline__ void transpose_tile(const float* __restrict__ src, int ld_src, int ncols_valid, const float* __restrict__ gain, bf16_t* __restrict__ dst,
                               int k0, int e0, float* tile  , int tid) {
    __syncthreads();
    f32x4 v[4];
#pragma unroll
    for (int p = 0; p < 4; ++p) {
        const int k = p * 16 + (tid >> 5), e = (tid & 31) * 4;
        const float* s = src + (size_t)(k0 + k) * ld_src + e0 + e;
        if (e0 + e + 3 < ncols_valid) v[p] = __builtin_nontemporal_load((const f32x4*)s);
        else { v[p] = (f32x4){0.f, 0.f, 0.f, 0.f};
#pragma unroll
            for (int i = 0; i < 4; ++i) if (e0 + e + i < ncols_valid) v[p][i] = s[i]; }
    }
#pragma unroll
    for (int p = 0; p < 4; ++p) {
        const int k = p * 16 + (tid >> 5), e = (tid & 31) * 4;
        const float g = gain ? gain[k0 + k] : 1.0f;
        *(f32x4*)(tile + k * 132 + e) = v[p] * g;
    }
    __syncthreads();
#pragma unroll
    for (int p = 0; p < 2; ++p) {
        const int e = (tid >> 3) + 64 * p, c = (tid & 7) * 8;
        u32x4 o;
        o.x = pack_bf2(tile[(c + 0) * 132 + e], tile[(c + 1) * 132 + e]);
        o.y = pack_bf2(tile[(c + 2) * 132 + e], tile[(c + 3) * 132 + e]);
        o.z = pack_bf2(tile[(c + 4) * 132 + e], tile[(c + 5) * 132 + e]);
        o.w = pack_bf2(tile[(c + 6) * 132 + e], tile[(c + 7) * 132 + e]);
        *(u32x4*)(dst + (size_t)(e0 + e) * 1024 + k0 + c) = o;
    }
}
template <int MODE>
__device__ __forceinline__ void phase0(const Params& p, char* smem, int tid, int i0, int di) {
    asm volatile("" : "+v"(tid));
    const int wv = tid >> 6, lane = tid & 63;
    const int N_TIN = 16 * 26, N_TOUT = 16 * 8, N_WM = 32, N_ROWS = T_TOK / 32;
    const int total = MODE == 0 ? N_TIN + N_ROWS : N_TOUT + N_WM;
    for (int it0 = i0; it0 < total; it0 += di) {
        const int it = MODE == 0 ? (it0 < N_TIN ? it0 : it0 + N_TOUT + N_WM) : it0 + N_TIN;
        if (it < N_TIN) {
            const int kt = it & 15, et = it >> 4;
            transpose_tile(p.w_in, DIN, DIN, p.norm_gain, p.w.WinT, kt * 64, et * 128, (float*)smem, tid);
        } else if (it < N_TIN + N_TOUT) {
            const int t = it - N_TIN, kt = t & 15, et = t >> 4;
            transpose_tile(p.w_out, DM, DM, nullptr, p.w.WoutT, kt * 64, et * 128, (float*)smem, tid);
        } else if (it < N_TIN + N_TOUT + N_WM) {
            const int t = it - N_TIN - N_TOUT;
#pragma unroll
            for (int q = 0; q < 4; ++q) {
                const int e = t * 2048 + q * 512 + tid, i = (e >> 7) & 127, j = e & 127;
                const float v = ((j >> 6) <= (i >> 6)) ? p.sgu_w[e] : 0.f;
                p.w.Wm[e] = f2bf(v);
            }
        } else {
            const int row0 = (it - N_TIN - N_TOUT - N_WM) * 32 + wv * 4;
            f32x4 v[4][4];
#pragma unroll
            for (int r = 0; r < 4; ++r)
#pragma unroll
                for (int i = 0; i < 4; ++i) v[r][i] = __builtin_nontemporal_load((const f32x4*)(p.x + (size_t)(row0 + r) * DM + i * 256 + lane * 4));
#pragma unroll
            for (int r = 0; r < 4; ++r) {
                float s = 0.f;
#pragma unroll
                for (int i = 0; i < 4; ++i) s += v[r][i][0] * v[r][i][0] + v[r][i][1] * v[r][i][1] + v[r][i][2] * v[r][i][2] + v[r][i][3] * v[r][i][3];
                s = wave_sum(s);
                if (lane == 0) p.w.rinv[row0 + r] = rsqrtf(s * (1.0f / DM) + EPS);
#pragma unroll
                for (int i = 0; i < 4; ++i) {
                    u32x2 o; o.x = pack_bf2(v[r][i][0], v[r][i][1]); o.y = pack_bf2(v[r][i][2], v[r][i][3]);
                    *(u32x2*)(p.w.xb + (size_t)(row0 + r) * DM + i * 256 + lane * 4) = o;
                }
            }
        }
    }
}

__device__ __forceinline__ float quad_sum(float v) { v += __shfl_xor(v, 16); v += __shfl_xor(v, 32); return v; }

__device__ __forceinline__ void p1_unit(const Params& p, int tb, int ct, char* smem, int tid, int st0 = 0, int pre = 0, int ntb = -1, int nct = 0) {
    asm volatile("" : "+v"(tid));
    const int wv = tid >> 6, lane = tid & 63, wm = wv >> 2, wn = wv & 3, fr = lane & 15, fq = lane >> 4;
    float* st = (float*)(smem + ST_OFF);
    float rr[4];
#pragma unroll
    for (int ni = 0; ni < 4; ++ni) rr[ni] = p.w.rinv[tb * 256 + wn * 64 + ni * 16 + fr];
    f32x4 acc[4][4];
    gemm_ring(p.w.WinT + (size_t)ct * 128 * DM, p.w.xb + (size_t)tb * 256 * DM, smem, acc, tid, st0, pre,
              ntb >= 0 ? p.w.WinT + (size_t)nct * 128 * DM : nullptr, ntb >= 0 ? p.w.xb + (size_t)ntb * 256 * DM : nullptr);
    u32x2 ov[4][4];
    bf16_t* dtile = nullptr;
    if (ct >= 4 && ct < 8) {
#pragma unroll
        for (int ni = 0; ni < 4; ++ni) {
            float s1 = 0.f, s2 = 0.f;
#pragma unroll
            for (int mi = 0; mi < 4; ++mi)
#pragma unroll
                for (int i = 0; i < 4; ++i) { const float gvv = gelu_tanh(acc[mi][ni][i] * rr[ni]); acc[mi][ni][i] = gvv; s1 += gvv; s2 += gvv * gvv; }
            s1 = quad_sum(s1); s2 = quad_sum(s2);
            if (fq == 0) { const int tl = wn * 64 + ni * 16 + fr; st[(tl * 2 + wm) * 2 + 0] = s1; st[(tl * 2 + wm) * 2 + 1] = s2; }
            __builtin_amdgcn_sched_barrier(0);
        }
        __syncthreads();
#pragma unroll
        for (int ni = 0; ni < 4; ++ni) {
            const int tl = wn * 64 + ni * 16 + fr;
            const f32x4 sv = *(const f32x4*)(st + tl * 4);
            const float mu = (sv[0] + sv[2]) * (1.0f / 128.0f);
            const float var = (sv[1] + sv[3]) * (1.0f / 128.0f) - mu * mu;
            const float rs = rsqrtf(fmaxf(var, 0.f) + EPS);
#pragma unroll
            for (int mi = 0; mi < 4; ++mi) {
                const f32x4 gn = *(const f32x4*)(p.sgu_ng + (ct - 4) * 128 + wm * 64 + mi * 16 + fq * 4);
                ov[mi][ni].x = pack_bf2((acc[mi][ni][0] - mu) * rs * gn[0], (acc[mi][ni][1] - mu) * rs * gn[1]);
                ov[mi][ni].y = pack_bf2((acc[mi][ni][2] - mu) * rs * gn[2], (acc[mi][ni][3] - mu) * rs * gn[3]);
            }
            __builtin_amdgcn_sched_barrier(0);
        }
        dtile = p.w.vn + (size_t)tb * 256 * 512 + (ct - 4) * 128;
    } else {
#pragma unroll
        for (int ni = 0; ni < 4; ++ni) {
            const int tok = tb * 256 + wn * 64 + ni * 16 + fr;
            const float r = rr[ni];
            f32x4 v[4];
#pragma unroll
            for (int mi = 0; mi < 4; ++mi) v[mi] = acc[mi][ni] * r;
            if (ct < 4) {
#pragma unroll
                for (int mi = 0; mi < 4; ++mi) { ov[mi][ni].x = pack_bf2(gelu_tanh(v[mi][0]), gelu_tanh(v[mi][1])); ov[mi][ni].y = pack_bf2(gelu_tanh(v[mi][2]), gelu_tanh(v[mi][3])); }
            } else if (ct < 12 || (ct >= 17 && ct < 21)) {
#pragma unroll
                for (int mi = 0; mi < 4; ++mi) { ov[mi][ni].x = pack_bf2(silu_f(v[mi][0]), silu_f(v[mi][1])); ov[mi][ni].y = pack_bf2(silu_f(v[mi][2]), silu_f(v[mi][3])); }
            } else if (ct < 16 || (ct == 16 && wm == 0)) {
                float ss = 0.f;
#pragma unroll
                for (int mi = 0; mi < 4; ++mi) ss += v[mi][0] * v[mi][0] + v[mi][1] * v[mi][1] + v[mi][2] * v[mi][2] + v[mi][3] * v[mi][3];
                ss = quad_sum(ss);
                const bool isq = ct < 16;
                const float sc = rsqrtf(ss * (1.0f / 64.0f) + EPS) * (isq ? (0.125f * 1.4426950408889634f) : 1.0f);
                const float* gain = isq ? p.qg : p.kg;
#pragma unroll
                for (int mi = 0; mi < 4; ++mi) {
                    const int d = mi * 16 + fq * 4;
                    const f32x4 gv = *(const f32x4*)(gain + d);
                    u32x2 o; o.x = pack_bf2(v[mi][0] * sc * gv[0], v[mi][1] * sc * gv[1]); o.y = pack_bf2(v[mi][2] * sc * gv[2], v[mi][3] * sc * gv[3]);
                    if (isq) ov[mi][ni] = o; else *(u32x2*)(p.w.kn + (size_t)tok * 64 + d) = o;
                }
            } else if (ct == 16) {
                const int b = tok >> 11, pos = tok & 2047;
#pragma unroll
                for (int mi = 0; mi < 4; ++mi)
#pragma unroll
                    for (int i = 0; i < 4; ++i) p.w.vt[((size_t)b * 64 + mi * 16 + fq * 4 + i) * SEQ + vt_pos(pos)] = f2bf(v[mi][i]);
            } else if (ct < 25) {
#pragma unroll
                for (int mi = 0; mi < 4; ++mi) { ov[mi][ni].x = pack_bf2(v[mi][0], v[mi][1]); ov[mi][ni].y = pack_bf2(v[mi][2], v[mi][3]); }
            } else if (wm == 0) {
                float s1 = 0.f;
#pragma unroll
                for (int mi = 0; mi < 4; ++mi) s1 += v[mi][0] + v[mi][1] + v[mi][2] + v[mi][3];
                s1 = quad_sum(s1);
                const float mu = s1 * (1.0f / 64.0f);
                float s2 = 0.f;
#pragma unroll
                for (int mi = 0; mi < 4; ++mi) { v[mi] = v[mi] - mu; s2 += v[mi][0] * v[mi][0] + v[mi][1] * v[mi][1] + v[mi][2] * v[mi][2] + v[mi][3] * v[mi][3]; }
                s2 = quad_sum(s2);
                const float rs = rsqrtf(s2 * (1.0f / 64.0f) + EPS);
#pragma unroll
                for (int mi = 0; mi < 4; ++mi) {
                    const int d = mi * 16 + fq * 4;
                    const f32x4 gv = *(const f32x4*)(p.ikg + d);
                    u32x2 o; o.x = pack_bf2(v[mi][0] * rs * gv[0], v[mi][1] * rs * gv[1]); o.y = pack_bf2(v[mi][2] * rs * gv[2], v[mi][3] * rs * gv[3]);
                    *(u32x2*)(p.w.kin + (size_t)tok * 64 + d) = o;
                }
            } else {
                if (fq < 2) *(f32x4*)(p.w.wi + (size_t)tok * 8 + fq * 4) = v[0] * 0.04419417382415922f;
            }
            __builtin_amdgcn_sched_barrier(0);
        }
        if (ct < 4) dtile = p.w.gu + (size_t)tb * 256 * 512 + ct * 128;
        else if (ct < 12) dtile = p.w.gza + (size_t)tb * 256 * 512 + (ct - 8) * 128;
        else if (ct < 16) dtile = p.w.qn + (size_t)tb * 256 * 512 + (ct - 12) * 128;
        else if (ct >= 17 && ct < 21) dtile = p.w.gz + (size_t)tb * 256 * 512 + (ct - 17) * 128;
        else if (ct >= 21 && ct < 25) dtile = p.w.qi + (size_t)tb * 256 * 512 + (ct - 21) * 128;
    }
    if (dtile) {
        bf16_t* img = (bf16_t*)(smem + st0 * RING_STAGE);
        __syncthreads();
#pragma unroll
        for (int hf = 0; hf < 2; ++hf) {
            if ((wn >> 1) == hf) {
#pragma unroll
                for (int ni = 0; ni < 4; ++ni)
#pragma unroll
                    for (int mi = 0; mi < 4; ++mi) *(u32x2*)(img + ((wn & 1) * 64 + ni * 16 + fr) * 136 + wm * 64 + mi * 16 + fq * 4) = ov[mi][ni];
            }
            __syncthreads();
#pragma unroll
            for (int ps = 0; ps < 4; ++ps) {
                const int row = ps * 32 + (tid >> 4), ck = (tid & 15) * 8;
                const u32x4 t = *(const u32x4*)(img + row * 136 + ck);
                *(u32x4*)(dtile + (size_t)(hf * 128 + row) * 512 + ck) = t;
            }
            if (hf == 0) __syncthreads();
        }
    }
}

__device__ __forceinline__ void p1_unit256(const Params& p, int tb, int d, char* smem, int tid, bool pre, int ntb, int nd, int nstb, int nsct) {
    f32x4 acc[8][4];
    gemm_ring256(p.w.WinT + (size_t)d * 256 * DM, p.w.xb + (size_t)tb * 256 * DM, smem, acc, tid, pre);
    asm volatile("" : "+v"(tid));
    const int wv = tid >> 6, lane = tid & 63, wm = wv >> 2, wn = wv & 3, fr = lane & 15, fq = lane >> 4;
    const int ct = 2 * d + wm;
    float rr[4];
#pragma unroll
    for (int ni = 0; ni < 4; ++ni) rr[ni] = p.w.rinv[tb * 256 + wn * 64 + ni * 16 + fr];
    __syncthreads();
    if (ntb >= 0) g2_prefetch0(p.w.WinT + (size_t)nd * 256 * DM, p.w.xb + (size_t)ntb * 256 * DM, smem, tid);
    else if (nstb >= 0) g1_prefetch0(p.w.WinT + (size_t)nsct * 128 * DM, p.w.xb + (size_t)nstb * 256 * DM, smem, tid);
    bf16_t* dbase = ct < 4 ? p.w.gu + ct * 128 : ct < 8 ? p.w.vn + (ct - 4) * 128 : ct < 12 ? p.w.gza + (ct - 8) * 128 : ct < 16 ? p.w.qn + (ct - 12) * 128
                  : ct < 21 ? p.w.gz + (ct - 17) * 128 : p.w.qi + (ct - 21) * 128;
    bf16_t* img = (bf16_t*)(smem + 65536 + wv * 8704);
#pragma unroll
    for (int hf = 0; hf < 2; ++hf) {
#pragma unroll
    for (int n2 = 0; n2 < 2; ++n2) {
        const int ni = hf * 2 + n2;
        const int tok = tb * 256 + wn * 64 + ni * 16 + fr;
        const float r = rr[ni];
        bf16_t* dst = img + (n2 * 16 + fr) * 136 + fq * 4;
        f32x4 v[8];
#pragma unroll
        for (int mi = 0; mi < 8; ++mi) v[mi] = acc[mi][ni] * r;
        if (ct < 4) {
#pragma unroll
            for (int mi = 0; mi < 8; ++mi) { u32x2 o; o.x = pack_bf2(gelu_tanh(v[mi][0]), gelu_tanh(v[mi][1])); o.y = pack_bf2(gelu_tanh(v[mi][2]), gelu_tanh(v[mi][3])); *(u32x2*)(dst + mi * 16) = o; }
        } else if (ct < 8) {
            float s1 = 0.f, s2 = 0.f;
#pragma unroll
            for (int mi = 0; mi < 8; ++mi)
#pragma unroll
                for (int i = 0; i < 4; ++i) { const float gvv = gelu_tanh(v[mi][i]); v[mi][i] = gvv; s1 += gvv; s2 += gvv * gvv; }
            s1 = quad_sum(s1); s2 = quad_sum(s2);
            const float mu = s1 * (1.0f / 128.0f);
            const float rs = rsqrtf(fmaxf(s2 * (1.0f / 128.0f) - mu * mu, 0.f) + EPS);
#pragma unroll
            for (int mi = 0; mi < 8; ++mi) {
                const f32x4 gn = *(const f32x4*)(p.sgu_ng + (ct - 4) * 128 + mi * 16 + fq * 4);
                u32x2 o; o.x = pack_bf2((v[mi][0] - mu) * rs * gn[0], (v[mi][1] - mu) * rs * gn[1]); o.y = pack_bf2((v[mi][2] - mu) * rs * gn[2], (v[mi][3] - mu) * rs * gn[3]);
                *(u32x2*)(dst + mi * 16) = o;
            }
        } else if (ct < 12 || (ct >= 17 && ct < 21)) {
#pragma unroll
            for (int mi = 0; mi < 8; ++mi) { u32x2 o; o.x = pack_bf2(silu_f(v[mi][0]), silu_f(v[mi][1])); o.y = pack_bf2(silu_f(v[mi][2]), silu_f(v[mi][3])); *(u32x2*)(dst + mi * 16) = o; }
        } else if (ct < 16) {
#pragma unroll
            for (int hh = 0; hh < 2; ++hh) {
                float ss = 0.f;
#pragma unroll
                for (int m4 = 0; m4 < 4; ++m4) { const f32x4 t = v[hh * 4 + m4]; ss += t[0] * t[0] + t[1] * t[1] + t[2] * t[2] + t[3] * t[3]; }
                ss = quad_sum(ss);
                const float sc = rsqrtf(ss * (1.0f / 64.0f) + EPS) * (0.125f * 1.4426950408889634f);
#pragma unroll
                for (int m4 = 0; m4 < 4; ++m4) {
                    const f32x4 gv = *(const f32x4*)(p.qg + m4 * 16 + fq * 4); const f32x4 t = v[hh * 4 + m4];
                    u32x2 o; o.x = pack_bf2(t[0] * sc * gv[0], t[1] * sc * gv[1]); o.y = pack_bf2(t[2] * sc * gv[2], t[3] * sc * gv[3]);
                    *(u32x2*)(dst + (hh * 4 + m4) * 16) = o;
                }
            }
        } else if (ct == 16) {
            float ss = 0.f;
#pragma unroll
            for (int m4 = 0; m4 < 4; ++m4) { const f32x4 t = v[m4]; ss += t[0] * t[0] + t[1] * t[1] + t[2] * t[2] + t[3] * t[3]; }
            ss = quad_sum(ss);
            const float sc = rsqrtf(ss * (1.0f / 64.0f) + EPS);
#pragma unroll
            for (int m4 = 0; m4 < 4; ++m4) {
                const f32x4 gv = *(const f32x4*)(p.kg + m4 * 16 + fq * 4); const f32x4 t = v[m4];
                u32x2 o; o.x = pack_bf2(t[0] * sc * gv[0], t[1] * sc * gv[1]); o.y = pack_bf2(t[2] * sc * gv[2], t[3] * sc * gv[3]);
                *(u32x2*)(p.w.kn + (size_t)tok * 64 + m4 * 16 + fq * 4) = o;
            }
            const int b = tok >> 11, pos = tok & 2047;
#pragma unroll
            for (int m4 = 0; m4 < 4; ++m4)
#pragma unroll
                for (int i = 0; i < 4; ++i) p.w.vt[((size_t)b * 64 + m4 * 16 + fq * 4 + i) * SEQ + vt_pos(pos)] = f2bf(v[4 + m4][i]);
        } else {
#pragma unroll
            for (int mi = 0; mi < 8; ++mi) { u32x2 o; o.x = pack_bf2(v[mi][0], v[mi][1]); o.y = pack_bf2(v[mi][2], v[mi][3]); *(u32x2*)(dst + mi * 16) = o; }
        }
        __builtin_amdgcn_sched_barrier(0);
    }
    if (ct != 16) {
        bf16_t* grow = dbase + (size_t)(tb * 256 + wn * 64 + hf * 32) * 512;
#pragma unroll
        for (int ps = 0; ps < 8; ++ps) {
            const int row = ps * 4 + (lane >> 4), ck = (lane & 15) * 8;
            const u32x4 t = *(const u32x4*)(img + row * 136 + ck);
            *(u32x4*)(grow + (size_t)row * 512 + ck) = t;
        }
    }
    }
}

__device__ __forceinline__ void phase1(const Params& p, char* smem, int tid) {
    const int x = blockIdx.x & 7, li = blockIdx.x >> 3;
    const bool xaw = (opaque_grid() == 256);
    const int jlim = xaw ? 96 : 768, jst = xaw ? 32 : (int)gridDim.x;
    bool pre = false;
    for (int j = xaw ? li : (int)blockIdx.x; j < jlim; j += jst) {
        const int tb = xaw ? x + 8 * (4 * (j / 48) + (j & 3)) : j / 12, d = xaw ? (j % 48) / 4 : j % 12;
        const int jn = j + jst;
        const int ntb = jn < jlim ? (xaw ? x + 8 * (4 * (jn / 48) + (jn & 3)) : jn / 12) : -1, nd = xaw ? (jn % 48) / 4 : jn % 12;
        const int nstb = (xaw && ntb < 0 && li < 16) ? x + 8 * (li >> 1) : -1;
        p1_unit256(p, tb, d, smem, tid, pre, ntb, nd, nstb, 24 + (li & 1));
        pre = true;
    }
    for (int u = xaw ? (li < 16 ? li : 128) : (int)blockIdx.x; u < (xaw ? 16 : 128); u += xaw ? 128 : (int)gridDim.x)
        p1_unit(p, xaw ? x + 8 * (u >> 1) : u >> 1, 24 + (u & 1), smem, tid, 0, xaw ? 2 : 0);
    if (xaw) { if (li >= 16) phase0<1>(p, smem, tid, x * 16 + (li - 16), 128); }
    else phase0<1>(p, smem, tid, (int)blockIdx.x, (int)gridDim.x);
}

#define VNT_ROW 136
struct SguOps { u32x4 r[4]; bf16x8 bw[4][2]; u32x2 guv[2][4], zv[2][4]; float bi[2]; };
__device__ __forceinline__ void sgu_load(const Params& p, int nb, int g, int tid, SguOps& o) {
    const int wv = tid >> 6, lane = tid & 63, wm = wv >> 2, wn = wv & 3, fr = lane & 15, fq = lane >> 4;
    const int j = tid >> 2, c0 = (tid & 3) * 32;
    {
        const bf16_t* src = p.w.vn + (size_t)(nb * 128 + j) * 512 + g * 128 + c0;
#pragma unroll
        for (int q = 0; q < 4; ++q) o.r[q] = *(const u32x4*)(src + q * 8);
    }
    const bf16_t* Wg = p.w.Wm + (size_t)g * 128 * 128;
#pragma unroll
    for (int ks = 0; ks < 4; ++ks)
#pragma unroll
        for (int i = 0; i < 2; ++i) o.bw[ks][i] = *(const bf16x8*)(Wg + (size_t)(wn * 32 + i * 16 + fr) * 128 + ks * 32 + fq * 8);
#pragma unroll
    for (int ni = 0; ni < 2; ++ni) {
        const int tl = wn * 32 + ni * 16 + fr;
        o.bi[ni] = p.sgu_b[g * 128 + tl];
#pragma unroll
        for (int mi = 0; mi < 4; ++mi) {
            const size_t off = (size_t)(nb * 128 + tl) * 512 + g * 128 + wm * 64 + mi * 16 + fq * 4;
            o.guv[ni][mi] = *(const u32x2*)(p.w.gu + off);
            o.zv[ni][mi] = *(const u32x2*)(p.w.gza + off);
        }
    }
}
template <bool NEXT>
__device__ __forceinline__ void sgu_compute(const Params& p, int nb, int g, char* smem, int tid, SguOps& o, int nnb, int ng, SguOps& nx) {
    const int wv = tid >> 6, lane = tid & 63, wm = wv >> 2, wn = wv & 3, fr = lane & 15, fq = lane >> 4;
    bf16_t* vnT = (bf16_t*)smem;
    float* st = (float*)(smem + 36864);
    const int j = tid >> 2, c0 = (tid & 3) * 32;
    __syncthreads();
#pragma unroll
    for (int q = 0; q < 4; ++q) {
        const unsigned wds[4] = {o.r[q].x, o.r[q].y, o.r[q].z, o.r[q].w};
#pragma unroll
        for (int e = 0; e < 4; ++e) {
            vnT[(c0 + q * 8 + 2 * e) * VNT_ROW + j] = (bf16_t)(wds[e] & 0xffffu);
            vnT[(c0 + q * 8 + 2 * e + 1) * VNT_ROW + j] = (bf16_t)(wds[e] >> 16);
        }
    }
    __syncthreads();
    if (NEXT) sgu_load(p, nnb, ng, tid, nx);
    f32x4 gnv[4];
#pragma unroll
    for (int mi = 0; mi < 4; ++mi) gnv[mi] = *(const f32x4*)(p.bng + g * 128 + wm * 64 + mi * 16 + fq * 4);
    f32x4 sacc[4][2];
#pragma unroll
    for (int mi = 0; mi < 4; ++mi) { sacc[mi][0] = (f32x4){0.f, 0.f, 0.f, 0.f}; sacc[mi][1] = (f32x4){0.f, 0.f, 0.f, 0.f}; }
#pragma unroll
    for (int ks = 0; ks < 4; ++ks) {
        bf16x8 a[4];
#pragma unroll
        for (int i = 0; i < 4; ++i) a[i] = *(const bf16x8*)(vnT + (wm * 64 + i * 16 + fr) * VNT_ROW + ks * 32 + fq * 8);
#pragma unroll
        for (int mi = 0; mi < 4; ++mi)
#pragma unroll
            for (int ni = 0; ni < 2; ++ni) sacc[mi][ni] = __builtin_amdgcn_mfma_f32_16x16x32_bf16(a[mi], o.bw[ks][ni], sacc[mi][ni], 0, 0, 0);
    }
#pragma unroll
    for (int ni = 0; ni < 2; ++ni) {
        const int tl = wn * 32 + ni * 16 + fr;
        float s2 = 0.f;
#pragma unroll
        for (int mi = 0; mi < 4; ++mi) {
            const u32x2 gv = o.guv[ni][mi];
            const float y0 = bf_lo(gv.x) * (sacc[mi][ni][0] + o.bi[ni]), y1 = bf_hi(gv.x) * (sacc[mi][ni][1] + o.bi[ni]);
            const float y2 = bf_lo(gv.y) * (sacc[mi][ni][2] + o.bi[ni]), y3 = bf_hi(gv.y) * (sacc[mi][ni][3] + o.bi[ni]);
            sacc[mi][ni] = (f32x4){y0, y1, y2, y3};
            s2 += y0 * y0 + y1 * y1 + y2 * y2 + y3 * y3;
        }
        s2 = quad_sum(s2);
        if (fq == 0) st[tl * 2 + wm] = s2;
    }
    __syncthreads();
#pragma unroll
    for (int ni = 0; ni < 2; ++ni) {
        const int tl = wn * 32 + ni * 16 + fr, tok = nb * 128 + tl;
        const float rs = rsqrtf((st[tl * 2] + st[tl * 2 + 1]) * (1.0f / 128.0f) + EPS);
#pragma unroll
        for (int mi = 0; mi < 4; ++mi) {
            const int ch = g * 128 + wm * 64 + mi * 16 + fq * 4;
            const f32x4 gn = gnv[mi];
            const u32x2 zz = o.zv[ni][mi];
            u32x2 ov;
            ov.x = pack_bf2(sacc[mi][ni][0] * rs * gn[0] * bf_lo(zz.x), sacc[mi][ni][1] * rs * gn[1] * bf_hi(zz.x));
            ov.y = pack_bf2(sacc[mi][ni][2] * rs * gn[2] * bf_lo(zz.y), sacc[mi][ni][3] * rs * gn[3] * bf_hi(zz.y));
            *(u32x2*)(p.w.mixed + (size_t)tok * 1024 + ch) = ov;
        }
    }
}

__device__ __forceinline__ void phase_sgu(const Params& p, char* smem, int tid) {
    asm volatile("" : "+v"(tid));
    const int x = blockIdx.x & 7, li = blockIdx.x >> 3;
    const bool xaw = (opaque_grid() == 256);
    if (xaw) {
        const int it = 2 * li, nb = 2 * (x + 8 * (it >> 3)) + ((it >> 2) & 1), g = it & 3;
        SguOps o0, o1;
        sgu_load(p, nb, g, tid, o0);
        sgu_compute<true>(p, nb, g, smem, tid, o0, nb, g + 1, o1);
        sgu_compute<false>(p, nb, g + 1, smem, tid, o1, 0, 0, o0);
    } else {
        for (int it = (int)blockIdx.x; it < 512; it += (int)gridDim.x) {
            SguOps o0;
            sgu_load(p, it >> 2, it & 3, tid, o0);
            sgu_compute<false>(p, it >> 2, it & 3, smem, tid, o0, 0, 0, o0);
        }
    }
}

#define LOG2E 1.4426950408889634f
__device__ __forceinline__ unsigned mono_key(float f) { const unsigned u = __float_as_uint(f); return u ^ ((unsigned)((int)u >> 31) | 0x80000000u); }
__device__ __forceinline__ int half_sum_i(int v) { v += __shfl_xor(v, 16); v += __shfl_xor(v, 8); v += __shfl_xor(v, 4); v += __shfl_xor(v, 2); v += __shfl_xor(v, 1); return v; }
__device__ __forceinline__ float half_min_f(float v) { v = fminf(v, __shfl_xor(v, 16)); v = fminf(v, __shfl_xor(v, 8)); v = fminf(v, __shfl_xor(v, 4)); v = fminf(v, __shfl_xor(v, 2)); v = fminf(v, __shfl_xor(v, 1)); return v; }

__device__ __forceinline__ void p2_item(const Params& p, int b, int qt, char* smem, int tid) {
    asm volatile("" : "+v"(tid));
    bf16_t* sK = (bf16_t*)smem;
    bf16_t* sV = sK + 2 * 64 * LROW;
    unsigned* maskL = (unsigned*)(smem + 36864);
    float* dnearL = (float*)(smem + 36864 + 8192);
    const int wv = tid >> 6, lane = tid & 63, G = lane >> 5, n = lane & 31;
    const int c = qt >> 1, nsteps = c + 1, ntiles = 2 * nsteps;
    const int tok0 = b * SEQ + qt * 32, pos0 = qt * 32;
    const int srow = tid >> 3, sch = (tid & 7) * 8;
    unsigned* mw_wave = maskL + wv * 256;
    __syncthreads();
    const int ql = n >> 3, h = n & 7;
    bf16x8 qfr[4]; u32x4 rk0, rv0; u32x2 gzp[2][4];
    const bf16_t* ksrc = p.w.kn + ((size_t)b * SEQ + srow) * 64 + sch;
    const bf16_t* vsrc = p.w.vt + ((size_t)b * 64 + srow) * SEQ + sch;
#define P2_PREFETCH() do { \
        const bf16_t* _qs = p.w.qn + (size_t)(tok0 + 4 * wv + ql) * 512 + h * 64 + 8 * G; \
        _Pragma("unroll") for (int _s = 0; _s < 4; ++_s) qfr[_s] = *(const bf16x8*)(_qs + 16 * _s); \
        rk0 = *(const u32x4*)(ksrc); rv0 = *(const u32x4*)(vsrc); } while (0)
    if (nsteps > 4) {
        bf16x8 afr[4];
        {
            const int ql = 2 * ((n >> 2) & 1) + (n >> 4), hd = 4 * ((n >> 3) & 1) + (n & 3);
            const bf16_t* src = p.w.qi + (size_t)(tok0 + 4 * wv + ql) * 512 + hd * 64 + 8 * G;
#pragma unroll
            for (int s = 0; s < 4; ++s) afr[s] = *(const bf16x8*)(src + 16 * s);
        }
        float w[16];
        {
            const float* wsrc = p.w.wi + (size_t)(tok0 + 4 * wv + 2 * G) * 8;
#pragma unroll
            for (int q4 = 0; q4 < 4; ++q4) { const f32x4 t = *(const f32x4*)(wsrc + 4 * q4); w[4 * q4] = t[0]; w[4 * q4 + 1] = t[1]; w[4 * q4 + 2] = t[2]; w[4 * q4 + 3] = t[3]; }
        }
        unsigned kk[128];
#pragma unroll
        for (int i = 0; i < 128; ++i) kk[i] = 0u;
        {
        const bf16_t* kisrc = p.w.kin + ((size_t)b * SEQ + srow) * 64 + sch;
        const bf16_t* kip = kisrc;
        u32x4 r0 = *(const u32x4*)(kisrc);
        *(u32x4*)(sK + srow * LROW + sch) = r0;
        __syncthreads();
#pragma unroll
        for (int st = 0; st < 32; ++st) {
            if (st < nsteps) {
                const bf16_t* buf = sK + (st & 1) * 64 * LROW;
                if (st + 1 < nsteps) {
                    kip += 64 * 64; asm volatile("" : "+v"(kip));
                    r0 = *(const u32x4*)(kip);
                }
                unsigned kq[2][2];
#pragma unroll
                for (int kt = 0; kt < 2; ++kt) {
                    f32x16 D;
#pragma unroll
                    for (int k = 0; k < 16; ++k) D[k] = 0.f;
#pragma unroll
                    for (int s = 0; s < 4; ++s) {
                        const bf16x8 bfr = *(const bf16x8*)(buf + (kt * 32 + n) * LROW + 16 * s + 8 * G);
                        D = __builtin_amdgcn_mfma_f32_32x32x16_bf16(afr[s], bfr, D, 0, 0, 0);
                    }
                    float s0 = 0.f, s1 = 0.f;
#pragma unroll
                    for (int k = 0; k < 8; ++k) {
                        const float r0 = __int_as_float(max(__float_as_int(D[k]), 0)), r1 = __int_as_float(max(__float_as_int(D[8 + k]), 0));
                        s0 = fmaf(w[k], r0, s0); s1 = fmaf(w[8 + k], r1, s1);
                    }
                    unsigned k0v = mono_key(s0), k1v = mono_key(s1);
                    asm volatile("" : "+v"(k0v), "+v"(k1v));
                    kq[kt][0] = k0v; kq[kt][1] = k1v;
                    __builtin_amdgcn_sched_barrier(0);
                }
#pragma unroll
                for (int a = 0; a < 2; ++a) {
                    const auto sw = __builtin_amdgcn_permlane32_swap(kq[0][a], kq[1][a], false, false);
                    kk[a * 32 + st] = sw[0];
                    kk[(2 + a) * 32 + st] = sw[1];
                }
                if (st + 1 < nsteps) {
                    bf16_t* nb = sK + ((st + 1) & 1) * 64 * LROW;
                    *(u32x4*)(nb + srow * LROW + sch) = r0;
                }
                __syncthreads();
            }
        }
        }
        P2_PREFETCH();
        {
#define SEL_COUNT(cand_, cnt_) do { unsigned a0_ = 0u, a1_ = 0u; \
            _Pragma("unroll") for (int g8 = 0; g8 < 4; ++g8) { if (g8 * 8 < nsteps) { \
                unsigned long long bm[8]; \
                asm volatile("v_cmp_ge_u32_e64 %2, %10, %18\n\tv_cmp_ge_u32_e64 %3, %11, %18\n\tv_cmp_ge_u32_e64 %4, %12, %18\n\tv_cmp_ge_u32_e64 %5, %13, %18\n\t" \
                             "v_cmp_ge_u32_e64 %6, %14, %18\n\tv_cmp_ge_u32_e64 %7, %15, %18\n\tv_cmp_ge_u32_e64 %8, %16, %18\n\tv_cmp_ge_u32_e64 %9, %17, %18\n\t" \
                             "v_addc_co_u32_e64 %0, %2, %0, 0, %2\n\tv_addc_co_u32_e64 %1, %3, %1, 0, %3\n\tv_addc_co_u32_e64 %0, %4, %0, 0, %4\n\tv_addc_co_u32_e64 %1, %5, %1, 0, %5\n\t" \
                             "v_addc_co_u32_e64 %0, %6, %0, 0, %6\n\tv_addc_co_u32_e64 %1, %7, %1, 0, %7\n\tv_addc_co_u32_e64 %0, %8, %0, 0, %8\n\tv_addc_co_u32_e64 %1, %9, %1, 0, %9" \
                             : "+v"(a0_), "+v"(a1_), "=&s"(bm[0]), "=&s"(bm[1]), "=&s"(bm[2]), "=&s"(bm[3]), "=&s"(bm[4]), "=&s"(bm[5]), "=&s"(bm[6]), "=&s"(bm[7]) \
                             : "v"(kk[q * 32 + g8 * 8 + 0]), "v"(kk[q * 32 + g8 * 8 + 1]), "v"(kk[q * 32 + g8 * 8 + 2]), "v"(kk[q * 32 + g8 * 8 + 3]), \
                               "v"(kk[q * 32 + g8 * 8 + 4]), "v"(kk[q * 32 + g8 * 8 + 5]), "v"(kk[q * 32 + g8 * 8 + 6]), "v"(kk[q * 32 + g8 * 8 + 7]), "v"(cand_)); } } \
            unsigned s_ = a0_ + a1_; \
            s_ += (unsigned)__builtin_amdgcn_update_dpp(0, (int)s_, 0x111, 0xf, 0xf, true); \
            s_ += (unsigned)__builtin_amdgcn_update_dpp(0, (int)s_, 0x112, 0xf, 0xf, true); \
            s_ += (unsigned)__builtin_amdgcn_update_dpp(0, (int)s_, 0x114, 0xf, 0xf, true); \
            s_ += (unsigned)__builtin_amdgcn_update_dpp(0, (int)s_, 0x118, 0xf, 0xf, true); \
            s_ += (unsigned)__builtin_amdgcn_update_dpp(0, (int)s_, 0x142, 0xa, 0xf, true); \
            s_ += (unsigned)__builtin_amdgcn_update_dpp(0, (int)s_, 0x143, 0xc, 0xf, true); \
            cnt_ = __builtin_amdgcn_readlane((int)s_, 63); } while (0)
#pragma unroll
        for (int q = 0; q < 4; ++q) {
            unsigned T = 0u; bool exact = false; int bit = 30, cnt;
            { const unsigned c0 = 0x80000000u; SEL_COUNT(c0, cnt); }
            if (cnt >= 256) {
                T = 0x80000000u; exact = (cnt == 256);
                if (!exact) {
                    unsigned mx = 0u;
#pragma unroll
                    for (int g8 = 0; g8 < 4; ++g8) {
                        if (g8 * 8 < nsteps) {
#pragma unroll
                            for (int j = 0; j < 8; ++j) mx = max(mx, kk[q * 32 + g8 * 8 + j]);
                        }
                    }
                    mx = max(mx, (unsigned)__builtin_amdgcn_update_dpp(0, (int)mx, 0x111, 0xf, 0xf, true));
                    mx = max(mx, (unsigned)__builtin_amdgcn_update_dpp(0, (int)mx, 0x112, 0xf, 0xf, true));
                    mx = max(mx, (unsigned)__builtin_amdgcn_update_dpp(0, (int)mx, 0x114, 0xf, 0xf, true));
                    mx = max(mx, (unsigned)__builtin_amdgcn_update_dpp(0, (int)mx, 0x118, 0xf, 0xf, true));
                    mx = max(mx, (unsigned)__builtin_amdgcn_update_dpp(0, (int)mx, 0x142, 0xa, 0xf, true));
                    mx = max(mx, (unsigned)__builtin_amdgcn_update_dpp(0, (int)mx, 0x143, 0xc, 0xf, true));
                    unsigned e = (unsigned)__builtin_amdgcn_readlane((int)mx, 63) >> 23;
                    for (int tries = 0; tries < 8 && e > 0x100u; ++tries, --e) {
                        const unsigned cand = e << 23;
                        SEL_COUNT(cand, cnt);
                        if (cnt >= 256) { T = cand; exact = (cnt == 256); bit = 22; break; }
                    }
                }
            }
            for (; bit >= 0 && !exact; --bit) {
                const unsigned cand = T | (1u << bit);
                SEL_COUNT(cand, cnt);
                if (cnt >= 256) T = cand;
                if (cnt == 256) exact = true;
            }
            if (exact) {
#pragma unroll
                for (int g4 = 0; g4 < 8; ++g4) {
                    if (g4 * 4 < nsteps) {
#pragma unroll
                        for (int j = 0; j < 4; ++j) {
                            const int pp = g4 * 4 + j;
                            const unsigned long long sb = __ballot(kk[q * 32 + pp] >= T);
                            if (lane == 0) { mw_wave[q * 64 + 2 * pp] = (unsigned)sb; mw_wave[q * 64 + 2 * pp + 1] = (unsigned)(sb >> 32); }
                        }
                    }
                }
            } else {
                int cg = 0;
#pragma unroll
                for (int g4 = 0; g4 < 8; ++g4) {
                    if (g4 * 4 < nsteps) {
#pragma unroll
                        for (int j = 0; j < 4; ++j) cg += __builtin_popcountll(__ballot(kk[q * 32 + g4 * 4 + j] > T));
                    }
                }
                const int need = 256 - cg;
                int run = 0;
#pragma unroll
                for (int g4 = 0; g4 < 8; ++g4) {
                    if (g4 * 4 < nsteps) {
#pragma unroll
                        for (int j = 0; j < 4; ++j) {
                            const int pp = g4 * 4 + j;
                            const unsigned key = kk[q * 32 + pp];
                            const bool eq = key == T;
                            const unsigned long long eb = __ballot(eq);
                            const int rank = run + (int)__builtin_amdgcn_mbcnt_hi((unsigned)(eb >> 32), __builtin_amdgcn_mbcnt_lo((unsigned)eb, 0u));
                            run += __builtin_popcountll(eb);
                            const unsigned long long sb = __ballot((key > T) || (eq && rank < need));
                            if (lane == 0) { mw_wave[q * 64 + 2 * pp] = (unsigned)sb; mw_wave[q * 64 + 2 * pp + 1] = (unsigned)(sb >> 32); }
                        }
                    }
                }
            }
        }
#undef SEL_COUNT
#pragma unroll
        for (int q = 0; q < 4; ++q) {
            const unsigned bits = (lane < ntiles) ? mw_wave[q * 64 + lane] : 0u;
            const int qp = pos0 + 4 * wv + q, wq = qp >> 5, bq = qp & 31;
            const unsigned lo_m = (lane < wq) ? bits : ((lane == wq) ? (bits & (0xffffffffu >> (31 - bq))) : 0u);
            const unsigned hi_m = (lane > wq) ? bits : ((lane == wq) ? (bits & (0xffffffffu << bq)) : 0u);
            float d = 1e9f;
            if (lo_m) d = (float)(qp - (32 * lane + 31 - __clz((int)lo_m)));
            if (hi_m) d = fminf(d, (float)(32 * lane + (__ffs((int)hi_m) - 1) - qp));
            d = fminf(d, __shfl_xor(d, 32)); d = half_min_f(d);
            if (lane == 0) dnearL[wv * 4 + q] = d;
        }
        }
    } else {
        P2_PREFETCH();
        for (int i = lane; i < 256; i += 64) mw_wave[i] = ((i & 63) < ntiles) ? 0xffffffffu : 0u;
        if (lane < 4) dnearL[wv * 4 + lane] = 0.f;
    }
    const float slope2 = exp2f(-(float)(h + 1)) * LOG2E;
    const float qposf = (float)(pos0 + 4 * wv + ql);
    f32x16 o0, o1, ol; float l = 0.f, dn = 0.f;
#pragma unroll
    for (int dt = 0; dt < 2; ++dt)
#pragma unroll
        for (int kq = 0; kq < 4; ++kq) gzp[dt][kq] = *(const u32x2*)(p.w.gz + (size_t)(tok0 + 4 * wv + ql) * 512 + h * 64 + dt * 32 + 8 * kq + 4 * G);
    bf16x8 ones;
#pragma unroll
    for (int k = 0; k < 8; ++k) ones[k] = (short)0x3f80;
    {
    __syncthreads();
    dn = dnearL[wv * 4 + ql];
    *(u32x4*)(sK + srow * LROW + sch) = rk0;
    *(u32x4*)(sV + srow * LROW + sch) = rv0;
    __syncthreads();
#pragma unroll
    for (int k = 0; k < 16; ++k) { o0[k] = 0.f; o1[k] = 0.f; ol[k] = 0.f; }
    l = 0.f;
    for (int st = 0; st < nsteps; ++st) {
        const bf16_t* bK = sK + (st & 1) * 64 * LROW;
        const bf16_t* bV = sV + (st & 1) * 64 * LROW;
        if (st + 1 < nsteps) {
            rk0 = *(const u32x4*)(ksrc + (size_t)(st + 1) * 64 * 64);
            rv0 = *(const u32x4*)(vsrc + (st + 1) * 64);
        }
#pragma unroll
        for (int kt = 0; kt < 2; ++kt) {
            const unsigned mwsh = mw_wave[ql * 64 + 2 * st + kt] >> (4 * G);
            const float kb = (float)(st * 64 + kt * 32 + 4 * G);
            f32x16 D;
            if (st < c) {
                const float e = slope2 * (kb - qposf + dn);
#pragma unroll
                for (int k = 0; k < 16; ++k) D[k] = fmaf(slope2, (float)((k & 3) + 8 * (k >> 2)), e);
            } else {
#pragma unroll
                for (int k = 0; k < 16; ++k) D[k] = -slope2 * (fabsf(qposf - kb - (float)((k & 3) + 8 * (k >> 2))) - dn);
            }
#pragma unroll
            for (int s = 0; s < 4; ++s) {
                const bf16x8 kfr = *(const bf16x8*)(bK + (kt * 32 + n) * LROW + 16 * s + 8 * G);
                D = __builtin_amdgcn_mfma_f32_32x32x16_bf16(kfr, qfr[s], D, 0, 0, 0);
            }
            unsigned pk[8];
#pragma unroll
            for (int k2 = 0; k2 < 8; ++k2) {
                float pe[2];
#pragma unroll
                for (int u = 0; u < 2; ++u) {
                    const int k = 2 * k2 + u, ck = (k & 3) + 8 * (k >> 2);
                    const float e = __builtin_amdgcn_exp2f(D[k]);
                    const int m = __builtin_amdgcn_sbfe((int)mwsh, ck, 1);
                    pe[u] = __uint_as_float(__float_as_uint(e) & (unsigned)m);
                }
                pk[k2] = pack_bf2(pe[0], pe[1]);
            }
            bf16x8 pf[2];
#pragma unroll
            for (int ks = 0; ks < 2; ++ks) {
                u32x4 t; t.x = pk[4 * ks]; t.y = pk[4 * ks + 1]; t.z = pk[4 * ks + 2]; t.w = pk[4 * ks + 3];
                pf[ks] = __builtin_bit_cast(bf16x8, t);
            }
#pragma unroll
            for (int ks = 0; ks < 2; ++ks) {
                const bf16x8 v0 = *(const bf16x8*)(bV + n * LROW + (2 * kt + ks) * 16 + 8 * G);
                const bf16x8 v1 = *(const bf16x8*)(bV + (32 + n) * LROW + (2 * kt + ks) * 16 + 8 * G);
                o0 = __builtin_amdgcn_mfma_f32_32x32x16_bf16(v0, pf[ks], o0, 0, 0, 0);
                o1 = __builtin_amdgcn_mfma_f32_32x32x16_bf16(v1, pf[ks], o1, 0, 0, 0);
                ol = __builtin_amdgcn_mfma_f32_32x32x16_bf16(ones, pf[ks], ol, 0, 0, 0);
            }
        }
        if (st + 1 < nsteps) {
            bf16_t* nK = sK + ((st + 1) & 1) * 64 * LROW; bf16_t* nV = sV + ((st + 1) & 1) * 64 * LROW;
            *(u32x4*)(nK + srow * LROW + sch) = rk0;
            *(u32x4*)(nV + srow * LROW + sch) = rv0;
        }
        __syncthreads();
    }
    }
    l = ol[0];
    const float il = 1.0f / l;
    float ss = 0.f;
#pragma unroll
    for (int k = 0; k < 16; ++k) { o0[k] *= il; o1[k] *= il; ss += o0[k] * o0[k] + o1[k] * o1[k]; }
    ss += __shfl_xor(ss, 32);
    const float rs = rsqrtf(ss * (1.0f / 64.0f) + EPS);
    bf16_t* oimg = (bf16_t*)(smem + 49152) + wv * (4 * 8 * 72);
#pragma unroll
    for (int dt = 0; dt < 2; ++dt)
#pragma unroll
        for (int kq = 0; kq < 4; ++kq) {
            const int d0 = dt * 32 + 8 * kq + 4 * G;
            const f32x4 gn = *(const f32x4*)(p.bng + 512 + h * 64 + d0);
            const u32x2 gzv = gzp[dt][kq];
            const float z0 = __uint_as_float(gzv.x << 16), z1 = __uint_as_float(gzv.x & 0xffff0000u), z2 = __uint_as_float(gzv.y << 16), z3 = __uint_as_float(gzv.y & 0xffff0000u);
            const float y0 = (dt ? o1[4 * kq] : o0[4 * kq]) * rs * gn[0] * z0, y1 = (dt ? o1[4 * kq + 1] : o0[4 * kq + 1]) * rs * gn[1] * z1;
            const float y2 = (dt ? o1[4 * kq + 2] : o0[4 * kq + 2]) * rs * gn[2] * z2, y3 = (dt ? o1[4 * kq + 3] : o0[4 * kq + 3]) * rs * gn[3] * z3;
            u32x2 o; o.x = pack_bf2(y0, y1); o.y = pack_bf2(y2, y3);
            *(u32x2*)(oimg + (ql * 8 + h) * 72 + d0) = o;
        }
#pragma unroll
    for (int q = 0; q < 4; ++q) {
        const u32x4 t = *(const u32x4*)(oimg + (q * 8 + (lane >> 3)) * 72 + (lane & 7) * 8);
        *(u32x4*)(p.w.mixed + (size_t)(tok0 + 4 * wv + q) * 1024 + 512 + lane * 8) = t;
    }
}

__device__ __forceinline__ void phase2(const Params& p, char* smem, int tid) {
    const int Gn = gridDim.x, bi = blockIdx.x;
    for (int rd = 0;; ++rd) {
        const int rank = rd * Gn + ((rd & 1) ? (Gn - 1 - bi) : bi);
        if (rank >= 512) break;
        const int c = 31 - (rank >> 4), j = rank & 15;
        p2_item(p, j >> 1, c * 2 + (j & 1), smem, tid);
    }
}

__device__ __forceinline__ void phase3(const Params& p, char* smem, int tid) {
    const bool xaw = (opaque_grid() == 256);
    for (int r = 0;; ++r) {
        int u;
        if (xaw) { if (r) break; u = ((blockIdx.x & 7) + 8 * (blockIdx.x >> 5)) * 4 + ((blockIdx.x >> 3) & 3); }
        else { u = blockIdx.x + r * gridDim.x; if (u >= 256) break; }
        const int tb = u >> 2, cb = u & 3;
        f32x4 acc[8][4];
        gemm_ring256(p.w.WoutT + (size_t)cb * 256 * DM, p.w.mixed + (size_t)tb * 256 * DM, smem, acc, tid);
        asm volatile("" : "+v"(tid));
        const int wv = tid >> 6, lane = tid & 63, wm = wv >> 2, wn = wv & 3, fr = lane & 15, fq = lane >> 4;
        float* img = (float*)(smem + wv * 16896);
        __syncthreads();
        const size_t gbase = (size_t)(tb * 256 + wn * 64) * DM + cb * 256 + wm * 128 + (lane & 31) * 4;
#pragma unroll
        for (int hf = 0; hf < 2; ++hf) {
#pragma unroll
            for (int n2 = 0; n2 < 2; ++n2)
#pragma unroll
                for (int mi = 0; mi < 8; ++mi) *(f32x4*)(img + (n2 * 16 + fr) * 132 + mi * 16 + fq * 4) = acc[mi][hf * 2 + n2];
#pragma unroll
            for (int bt = 0; bt < 2; ++bt) {
                f32x4 xv[8];
#pragma unroll
                for (int ps = 0; ps < 8; ++ps) {
                    const int row = (bt * 8 + ps) * 2 + (lane >> 5);
                    xv[ps] = __builtin_nontemporal_load((const f32x4*)(p.x + gbase + (size_t)(hf * 32 + row) * DM));
                }
#pragma unroll
                for (int ps = 0; ps < 8; ++ps) {
                    const int row = (bt * 8 + ps) * 2 + (lane >> 5);
                    const f32x4 t = *(const f32x4*)(img + row * 132 + (lane & 31) * 4);
                    __builtin_nontemporal_store(xv[ps] + t, (f32x4*)(p.out + gbase + (size_t)(hf * 32 + row) * DM));
                }
            }
        }
    }
}

#define XB_TMO      128
#define XB_XCNT(j)  (256  + 64 * (j))
#define XB_XSUB(j)  (1280 + 64 * (j))
#define XB_XGEN(j)  (2304 + 64 * (j))
#define XB_TOP      3328
#define XB_TOPGEN   3392
#define XCD_BAR_WORDS 3456
#define XB_SPIN_CAP (1u << 18)
#define XLAS __attribute__((address_space(3)))
__device__ __forceinline__ unsigned xb_ld(unsigned* p)              { return __hip_atomic_load(p, __ATOMIC_RELAXED, __HIP_MEMORY_SCOPE_AGENT); }
__device__ __forceinline__ unsigned xb_add(unsigned* p, unsigned v) { return __hip_atomic_fetch_add(p, v, __ATOMIC_RELAXED, __HIP_MEMORY_SCOPE_AGENT); }
__device__ __forceinline__ unsigned xb_xcc_id() { return (unsigned)__builtin_amdgcn_s_getreg((3 << 11) | 20) & 0xFu; }
#define XB_SPIN(cond, bar) do { unsigned _sp = 0; while (cond) { __builtin_amdgcn_s_sleep(1); \
    if ((++_sp & 255u) == 0u) { if (xb_ld(&(bar)[XB_TMO])) break; if (_sp > XB_SPIN_CAP) { atomicAdd(&(bar)[XB_TMO], 1u); break; } } } } while (0)
struct XcdBarrier { unsigned* bar; unsigned x; volatile XLAS unsigned* st; };
__device__ __forceinline__ XcdBarrier xcd_barrier_post(unsigned* bar, volatile XLAS unsigned* st) {
    XcdBarrier b; b.bar = bar; b.x = xb_xcc_id(); b.st = st;
    if (threadIdx.x == 0) (void)xb_add(&bar[XB_XCNT(b.x)], 1u);
    return b;
}
__device__ __forceinline__ void xcd_barrier_complete(unsigned* bar, unsigned x, unsigned& nloc, unsigned& nx) {
    const unsigned G = gridDim.x * gridDim.y * gridDim.z;
    unsigned sum, cnt, mine, sp = 0u;
    for (;;) {
        sum = 0u; cnt = 0u; mine = 0u;
#pragma unroll
        for (unsigned j = 0; j < 16; ++j) { const unsigned c = xb_ld(&bar[XB_XCNT(j)]); sum += c; cnt += (c > 0u) ? 1u : 0u; mine = (j == x) ? c : mine; }
        if (sum == G) break;
        __builtin_amdgcn_s_sleep(1);
        if ((++sp & 255u) == 0u) { if (xb_ld(&bar[XB_TMO])) break; if (sp > XB_SPIN_CAP) { atomicAdd(&bar[XB_TMO], 1u); break; } }
    }
    nloc = mine > 0u ? mine : 1u; nx = cnt > 0u ? cnt : 1u;
}
__device__ __forceinline__ void xcd_barrier(const XcdBarrier& b) {
    asm volatile("s_waitcnt vmcnt(0)" ::: "memory");
    __syncthreads();
    int t0 = threadIdx.x; asm volatile("" : "+v"(t0));
    if (t0 == 0) {
        unsigned* bar = b.bar;
        __builtin_amdgcn_s_waitcnt(0);
        unsigned nloc = b.st[0], nx = b.st[1];
        if (nloc == 0u) { xcd_barrier_complete(bar, b.x, nloc, nx); b.st[0] = nloc; b.st[1] = nx; }
        const unsigned old = xb_add(&bar[XB_XSUB(b.x)], 1u);
        const unsigned gen = old / nloc;
        if (old + 1u == (gen + 1u) * nloc) {
            __builtin_amdgcn_fence(__ATOMIC_RELEASE, "agent");
            asm volatile("s_waitcnt vmcnt(0)" ::: "memory");
            const unsigned og = xb_add(&bar[XB_TOP], 1u);
            const unsigned tg = og / nx;
            if (og + 1u == (tg + 1u) * nx) xb_add(&bar[XB_TOPGEN], 1u);
            else XB_SPIN(xb_ld(&bar[XB_TOPGEN]) == tg, bar);
            __builtin_amdgcn_fence(__ATOMIC_ACQUIRE, "agent");
            xb_add(&bar[XB_XGEN(b.x)], 1u);
            asm volatile("s_waitcnt vmcnt(0)" ::: "memory");
        } else {
            XB_SPIN(xb_ld(&bar[XB_XGEN(b.x)]) == gen, bar);
            __builtin_amdgcn_fence(__ATOMIC_ACQUIRE, "agent");
            asm volatile("s_waitcnt vmcnt(0)" ::: "memory");
        }
    }
    __syncthreads();
}

__global__ void __launch_bounds__(NT, 2) mega_kernel(Params p, int mask) {
    __shared__ __attribute__((aligned(16))) char smem[SMEM_BYTES + 16];
    cg::grid_group grid = cg::this_grid();
    int tid = threadIdx.x;
    volatile XLAS unsigned* xst = (volatile XLAS unsigned*)(smem + SMEM_BYTES);
    if (tid < 4) xst[tid] = 0u;
    __syncthreads();
    const XcdBarrier xb = xcd_barrier_post(p.w.bar, xst);
    if (mask) grid.sync();
    phase0<0>(p, smem, tid, (int)blockIdx.x, (int)gridDim.x); xcd_barrier(xb);
    phase1(p, smem, tid);    xcd_barrier(xb);
    phase_sgu(p, smem, tid);
    phase2(p, smem, tid);    xcd_barrier(xb);
    phase3(p, smem, tid);
}

extern "C" void kernel_launch(void* const* d_in, const int* in_sizes, int n_in, void* d_out, int out_size, void* d_ws, size_t ws_size,
                              hipStream_t stream) {
    const float* x = (const float*)d_in[0];
    const float* norm_gain = (const float*)d_in[1];
    const float* w_in = (const float*)d_in[2];
    const float* sgu_ng = (const float*)d_in[3];
    const float* sgu_w = (const float*)d_in[4];
    const float* sgu_b = (const float*)d_in[5];
    const float* qg = (const float*)d_in[6];
    const float* kg = (const float*)d_in[7];
    const float* ikg = (const float*)d_in[8];
    const float* bng = (const float*)d_in[9];
    const float* w_out = (const float*)d_in[10];
    float* out = (float*)d_out;
    WS w = make_ws(d_ws);
    Params p{};
    p.x = x; p.norm_gain = norm_gain; p.w_in = w_in; p.sgu_ng = sgu_ng; p.sgu_w = sgu_w; p.sgu_b = sgu_b;
    p.qg = qg; p.kg = kg; p.ikg = ikg; p.bng = bng; p.w_out = w_out; p.out = out; p.w = w;
    static int grid_blocks = 0;
    if (!grid_blocks) {
        int dev = 0, cus = 0, per_cu = 0;
        (void)hipGetDevice(&dev);
        (void)hipDeviceGetAttribute(&cus, hipDeviceAttributeMultiprocessorCount, dev);
        (void)hipOccupancyMaxActiveBlocksPerMultiprocessor(&per_cu, mega_kernel, NT, 0);
        if (per_cu > 1) per_cu = 1;
        if (per_cu < 1) per_cu = 1;
        grid_blocks = cus * per_cu;
    }
    int mask1 = 0;
    (void)hipMemsetAsync(w.bar, 0, (size_t)4096 * 4, stream);
    {
        void* args[] = {&p, &mask1};
        hipError_t e = hipLaunchCooperativeKernel((void*)mega_kernel, dim3(grid_blocks), dim3(NT), args, 0, stream);
        if (e != hipSuccess) fprintf(stderr, "cooperative launch failed: %s (grid %d)\n", hipGetErrorString(e), grid_blocks);
    }
}
```

```cpp
#include <hip/hip_runtime.h>
#include <hip/hip_cooperative_groups.h>
#include <stdint.h>
#include <cstdio>
namespace cg = cooperative_groups;

typedef unsigned short bf16_t;
typedef short bf16x8 __attribute__((ext_vector_type(8)));
typedef float f32x4 __attribute__((ext_vector_type(4)));
typedef float f32x16 __attribute__((ext_vector_type(16)));
typedef unsigned u32x4 __attribute__((ext_vector_type(4)));
typedef unsigned u32x2 __attribute__((ext_vector_type(2)));

#define T_TOK 16384
#define SEQ 2048
#define NB 8
#define DM 1024
#define DIN 3272
#define EPS 1e-6f

__device__ __forceinline__ float bf2f(bf16_t v) { return __uint_as_float(((unsigned)v) << 16); }
__device__ __forceinline__ bf16_t f2bf(float f) {
    unsigned u = __float_as_uint(f);
    u += 0x7fffu + ((u >> 16) & 1u);
    return (bf16_t)(u >> 16);
}
__device__ __forceinline__ float gelu_tanh(float x) {
    const float t = x * x * 0.044715f + 1.0f;
    const float e = __builtin_amdgcn_exp2f(x * t * (-2.0f * 0.7978845608028654f * 1.4426950408889634f));
    return x * __builtin_amdgcn_rcpf(1.0f + e);
}
__device__ __forceinline__ float silu_f(float x) { return x * __builtin_amdgcn_rcpf(1.0f + __builtin_amdgcn_exp2f(x * -1.4426950408889634f)); }
__device__ __forceinline__ float wave_sum(float v) {
#pragma unroll
    for (int o = 32; o >= 1; o >>= 1) v += __shfl_xor(v, o);
    return v;
}
__device__ __forceinline__ int perm16(int k) { return k < 4 ? k : (k < 8 ? k + 4 : (k < 12 ? k - 4 : k)); }
__device__ __forceinline__ int vt_pos(int s) { return (s & ~15) | perm16(s & 15); }

struct WS {
    bf16_t* qn;
    bf16_t* qi;
    bf16_t* gz;
    bf16_t* mixed;
    bf16_t* kn;
    bf16_t* kin;
    bf16_t* vt;
    float* wi;
    float* rinv;
    bf16_t* xb;
    bf16_t* WinT;
    bf16_t* WoutT;
    bf16_t* Wm;
    bf16_t* gu;
    bf16_t* vn;
    bf16_t* gza;
    unsigned* bar;
};
static WS make_ws(void* d_ws) {
    char* p = (char*)d_ws; WS w;
    auto take = [&](size_t bytes) { char* r = p; p += (bytes + 255) & ~(size_t)255; return r; };
    w.qn = (bf16_t*)take((size_t)T_TOK * 512 * 2);
    w.qi = (bf16_t*)take((size_t)T_TOK * 512 * 2);
    w.gz = (bf16_t*)take((size_t)T_TOK * 512 * 2);
    w.mixed = (bf16_t*)take((size_t)T_TOK * 1024 * 2);
    w.kn = (bf16_t*)take((size_t)T_TOK * 64 * 2);
    w.kin = (bf16_t*)take((size_t)T_TOK * 64 * 2);
    w.vt = (bf16_t*)take((size_t)T_TOK * 64 * 2);
    w.wi = (float*)take((size_t)T_TOK * 8 * 4);
    w.rinv = (float*)take((size_t)T_TOK * 4);
    w.xb = (bf16_t*)take((size_t)T_TOK * 1024 * 2);
    w.WinT = (bf16_t*)take((size_t)3328 * 1024 * 2);
    w.WoutT = (bf16_t*)take((size_t)1024 * 1024 * 2);
    w.Wm = (bf16_t*)take((size_t)4 * 128 * 128 * 2);
    w.gu = (bf16_t*)take((size_t)T_TOK * 512 * 2);
    w.vn = (bf16_t*)take((size_t)T_TOK * 512 * 2);
    w.gza = (bf16_t*)take((size_t)T_TOK * 512 * 2);
    w.bar = (unsigned*)take((size_t)4096 * 4);
    return w;
}

#define LAS __attribute__((address_space(3)))
#define NT 512
#define LROW 72
#define RING_STAGE 49152
#define RING_BYTES (3 * RING_STAGE)
#define ST_OFF RING_BYTES
#define SMEM_BYTES (RING_BYTES + 4096)

struct Params {
    const float* x; const float* norm_gain; const float* w_in; const float* sgu_ng; const float* sgu_w; const float* sgu_b;
    const float* qg; const float* kg; const float* ikg; const float* bng; const float* w_out; float* out;
    WS w;
};

typedef float f32x2 __attribute__((ext_vector_type(2)));
typedef __bf16 hbf16x2 __attribute__((ext_vector_type(2)));
__device__ __forceinline__ unsigned pack_bf2(float lo, float hi) {
    const f32x2 v = {lo, hi};
    return __builtin_bit_cast(unsigned, __builtin_convertvector(v, hbf16x2));
}
__device__ __forceinline__ float bf_lo(unsigned u) { return __uint_as_float(u << 16); }
__device__ __forceinline__ float bf_hi(unsigned u) { return __uint_as_float(u & 0xffff0000u); }

__device__ __forceinline__ int opaque_grid() { int g = (int)gridDim.x; asm volatile("" : "+s"(g)); return g; }
#define GWAIT_V(n) asm volatile("s_waitcnt vmcnt(" #n ")" ::: "memory")
#define GBAR() do { __builtin_amdgcn_s_barrier(); asm volatile("" ::: "memory"); } while (0)
__device__ __forceinline__ void gemm_ring(const bf16_t* __restrict__ Wt, const bf16_t* __restrict__ Xt, char* smem, f32x4 (&acc)[4][4], int tid,
                                          int st0 = 0, int pre = 0, const bf16_t* __restrict__ nWt = nullptr, const bf16_t* __restrict__ nXt = nullptr) {
    const int wv = __builtin_amdgcn_readfirstlane(tid >> 6), lane = tid & 63, wm = wv >> 2, wn = wv & 3, fr = lane & 15, fq = lane >> 4;
    LAS char* lds = (LAS char*)smem;
    const int sc = (lane & 7) ^ ((((wv & 1) << 2) + (lane >> 4)) & 7);
    const bf16_t* gX = Xt + (size_t)(wv * 8 + (lane >> 3)) * DM + sc * 8;
    const bf16_t* gW = Wt + (size_t)(wv * 8 + (lane >> 3)) * DM + sc * 8;
    const bool has_next = nWt != nullptr;
    const bf16_t* gX2 = (has_next ? nXt : Xt) + (size_t)(wv * 8 + (lane >> 3)) * DM + sc * 8;
    const bf16_t* gW2 = (has_next ? nWt : Wt) + (size_t)(wv * 8 + (lane >> 3)) * DM + sc * 8;
#define GSTAGE_N(st, k0) do { LAS char* _b = lds + (st) * RING_STAGE + wv * 1024; \
        _Pragma("unroll") for (int _i = 0; _i < 4; ++_i) __builtin_amdgcn_global_load_lds((const unsigned*)(gX2 + (size_t)_i * 64 * DM + (k0)), (LAS unsigned*)(_b + _i * 8192), 16, 0, 0); \
        _Pragma("unroll") for (int _i = 0; _i < 2; ++_i) __builtin_amdgcn_global_load_lds((const unsigned*)(gW2 + (size_t)_i * 64 * DM + (k0)), (LAS unsigned*)(_b + 32768 + _i * 8192), 16, 0, 0); } while (0)
#define GSTAGE(st, k0) do { LAS char* _b = lds + (st) * RING_STAGE + wv * 1024; \
        _Pragma("unroll") for (int _i = 0; _i < 4; ++_i) __builtin_amdgcn_global_load_lds((const unsigned*)(gX + (size_t)_i * 64 * DM + (k0)), (LAS unsigned*)(_b + _i * 8192), 16, 0, 0); \
        _Pragma("unroll") for (int _i = 0; _i < 2; ++_i) __builtin_amdgcn_global_load_lds((const unsigned*)(gW + (size_t)_i * 64 * DM + (k0)), (LAS unsigned*)(_b + 32768 + _i * 8192), 16, 0, 0); } while (0)
    const int sl0 = ((fq) ^ (fr >> 1)) << 4, sl1 = ((4 + fq) ^ (fr >> 1)) << 4;
    const int offX = wn * 8192 + fr * 128, offW = 32768 + wm * 8192 + fr * 128;
#pragma unroll
    for (int mi = 0; mi < 4; ++mi)
#pragma unroll
        for (int ni = 0; ni < 4; ++ni) acc[mi][ni] = (f32x4){0.f, 0.f, 0.f, 0.f};
    const int s1 = (st0 == 2) ? 0 : st0 + 1, s2 = (s1 == 2) ? 0 : s1 + 1;
    GWAIT_V(0);
    GBAR();
    if (pre == 0) GSTAGE(st0, 0);
    if (pre != 1) GSTAGE(s1, 64);
    GSTAGE(s2, 128);
    bf16x8 A0[4], B0[4], A1[4], B1[4];
#define GLDFRAG(A_, B_, sb_, sl_) do { _Pragma("unroll") for (int _i = 0; _i < 4; ++_i) { \
        A_[_i] = *(const LAS bf16x8*)((sb_) + offW + _i * 2048 + (sl_)); B_[_i] = *(const LAS bf16x8*)((sb_) + offX + _i * 2048 + (sl_)); } } while (0)
#define GMMA(A_, B_) do { _Pragma("unroll") for (int _m = 0; _m < 4; ++_m) _Pragma("unroll") for (int _n = 0; _n < 4; ++_n) \
        acc[_m][_n] = __builtin_amdgcn_mfma_f32_16x16x32_bf16(A_[_m], B_[_n], acc[_m][_n], 0, 0, 0); } while (0)
#define GMMA_ROW(A_, B_, m_) do { __builtin_amdgcn_s_setprio(1); _Pragma("unroll") for (int _n = 0; _n < 4; ++_n) \
        acc[m_][_n] = __builtin_amdgcn_mfma_f32_16x16x32_bf16(A_[m_], B_[_n], acc[m_][_n], 0, 0, 0); __builtin_amdgcn_s_setprio(0); } while (0)
    if (pre == 0) { GWAIT_V(12); GBAR(); }
    GLDFRAG(A0, B0, lds + st0 * RING_STAGE, sl0);
    int st = st0;
    for (int kt = 0; kt < 16; ++kt) {
        const LAS char* sb = lds + st * RING_STAGE;
        const int sn = (st == 2) ? 0 : st + 1;
        GMMA_ROW(A0, B0, 0);
        __builtin_amdgcn_sched_barrier(0);
        GLDFRAG(A1, B1, sb, sl1);
        __builtin_amdgcn_sched_barrier(0);
        GMMA_ROW(A0, B0, 1); GMMA_ROW(A0, B0, 2); GMMA_ROW(A0, B0, 3);
        __builtin_amdgcn_sched_barrier(0);
        if (kt < 15) {
            if (kt < 14 || has_next) GWAIT_V(6); else GWAIT_V(0);
            asm volatile("s_waitcnt lgkmcnt(0)" ::: "memory");
            GBAR();
            if (wv < 4) {
                if (kt + 3 < 16) GSTAGE(st, (kt + 3) * 64);
                else if (has_next) GSTAGE_N(st, (kt - 13) * 64);
            }
        }
        GMMA_ROW(A1, B1, 0);
        __builtin_amdgcn_sched_barrier(0);
        if (kt < 15) GLDFRAG(A0, B0, lds + sn * RING_STAGE, sl0);
        __builtin_amdgcn_sched_barrier(0);
        GMMA_ROW(A1, B1, 1); GMMA_ROW(A1, B1, 2); GMMA_ROW(A1, B1, 3);
        __builtin_amdgcn_sched_barrier(0);
        if (wv >= 4 && kt < 15) {
            if (kt + 3 < 16) GSTAGE(st, (kt + 3) * 64);
            else if (has_next) GSTAGE_N(st, (kt - 13) * 64);
        }
        __builtin_amdgcn_sched_barrier(0);
        st = sn;
    }
#undef GMMA_ROW
#undef GLDFRAG
#undef GMMA
#undef GSTAGE
#undef GSTAGE_N
}

#define R2_STAGE 65536
__device__ __forceinline__ void gemm_ring256(const bf16_t* __restrict__ Wt, const bf16_t* __restrict__ Xt, char* smem, f32x4 (&acc)[8][4], int tid, bool pre = false) {
    const int wv = __builtin_amdgcn_readfirstlane(tid >> 6), lane = tid & 63, wm = wv >> 2, wn = wv & 3, fr = lane & 15, fq = lane >> 4;
    LAS char* lds = (LAS char*)smem;
    const int sc = (lane & 7) ^ ((((wv & 1) << 2) + (lane >> 4)) & 7);
    const bf16_t* gX = Xt + (size_t)(wv * 8 + (lane >> 3)) * DM + sc * 8;
    const bf16_t* gW = Wt + (size_t)(wv * 8 + (lane >> 3)) * DM + sc * 8;
#define G2STAGE(st, k0) do { LAS char* _b = lds + (st) * R2_STAGE + wv * 1024; \
        _Pragma("unroll") for (int _i = 0; _i < 4; ++_i) __builtin_amdgcn_global_load_lds((const unsigned*)(gX + (size_t)_i * 64 * DM + (k0)), (LAS unsigned*)(_b + _i * 8192), 16, 0, 0); \
        _Pragma("unroll") for (int _i = 0; _i < 4; ++_i) __builtin_amdgcn_global_load_lds((const unsigned*)(gW + (size_t)_i * 64 * DM + (k0)), (LAS unsigned*)(_b + 32768 + _i * 8192), 16, 0, 0); } while (0)
    const int sl0 = ((fq) ^ (fr >> 1)) << 4, sl1 = ((4 + fq) ^ (fr >> 1)) << 4;
    const int offX = wn * 8192 + fr * 128, offW = 32768 + wm * 16384 + fr * 128;
#pragma unroll
    for (int mi = 0; mi < 8; ++mi)
#pragma unroll
        for (int ni = 0; ni < 4; ++ni) acc[mi][ni] = (f32x4){0.f, 0.f, 0.f, 0.f};
    GWAIT_V(0);
    GBAR();
    if (!pre) G2STAGE(0, 0);
    G2STAGE(1, 64);
    bf16x8 A0[8], B0[4], A1[8], B1[4];
#define G2LDFRAG(A_, B_, sb_, sl_) do { _Pragma("unroll") for (int _i = 0; _i < 8; ++_i) A_[_i] = *(const LAS bf16x8*)((sb_) + offW + _i * 2048 + (sl_)); \
        _Pragma("unroll") for (int _i = 0; _i < 4; ++_i) B_[_i] = *(const LAS bf16x8*)((sb_) + offX + _i * 2048 + (sl_)); } while (0)
#define G2MMA_ROW(A_, B_, m_) do { __builtin_amdgcn_s_setprio(1); _Pragma("unroll") for (int _n = 0; _n < 4; ++_n) \
        acc[m_][_n] = __builtin_amdgcn_mfma_f32_16x16x32_bf16(A_[m_], B_[_n], acc[m_][_n], 0, 0, 0); __builtin_amdgcn_s_setprio(0); } while (0)
    if (!pre) { GWAIT_V(8); GBAR(); }
    G2LDFRAG(A0, B0, lds, sl0);
    for (int kt = 0; kt < 16; ++kt) {
        const int s = kt & 1;
        const LAS char* sb = lds + s * R2_STAGE;
        G2MMA_ROW(A0, B0, 0);
        __builtin_amdgcn_sched_barrier(0);
        G2LDFRAG(A1, B1, sb, sl1);
        __builtin_amdgcn_sched_barrier(0);
        G2MMA_ROW(A0, B0, 1); G2MMA_ROW(A0, B0, 2); G2MMA_ROW(A0, B0, 3); G2MMA_ROW(A0, B0, 4); G2MMA_ROW(A0, B0, 5); G2MMA_ROW(A0, B0, 6); G2MMA_ROW(A0, B0, 7);
        __builtin_amdgcn_sched_barrier(0);
        if (kt < 15) {
            GWAIT_V(0);
            asm volatile("s_waitcnt lgkmcnt(0)" ::: "memory");
            GBAR();
            if (kt + 2 < 16 && wv < 4) G2STAGE(s, (kt + 2) * 64);
        }
        G2MMA_ROW(A1, B1, 0);
        __builtin_amdgcn_sched_barrier(0);
        if (kt < 15) G2LDFRAG(A0, B0, lds + (s ^ 1) * R2_STAGE, sl0);
        __builtin_amdgcn_sched_barrier(0);
        G2MMA_ROW(A1, B1, 1); G2MMA_ROW(A1, B1, 2); G2MMA_ROW(A1, B1, 3); G2MMA_ROW(A1, B1, 4); G2MMA_ROW(A1, B1, 5); G2MMA_ROW(A1, B1, 6); G2MMA_ROW(A1, B1, 7);
        __builtin_amdgcn_sched_barrier(0);
        if (kt + 2 < 16 && wv >= 4) G2STAGE(s, (kt + 2) * 64);
        __builtin_amdgcn_sched_barrier(0);
    }
#undef G2MMA_ROW
#undef G2LDFRAG
#undef G2STAGE
}

__device__ __forceinline__ void g2_prefetch0(const bf16_t* __restrict__ Wt, const bf16_t* __restrict__ Xt, char* smem, int tid) {
    const int wv = __builtin_amdgcn_readfirstlane(tid >> 6), lane = tid & 63;
    LAS char* lds = (LAS char*)smem;
    const int sc = (lane & 7) ^ ((((wv & 1) << 2) + (lane >> 4)) & 7);
    const bf16_t* gX = Xt + (size_t)(wv * 8 + (lane >> 3)) * DM + sc * 8;
    const bf16_t* gW = Wt + (size_t)(wv * 8 + (lane >> 3)) * DM + sc * 8;
    LAS char* b = lds + wv * 1024;
#pragma unroll
    for (int i = 0; i < 4; ++i) __builtin_amdgcn_global_load_lds((const unsigned*)(gX + (size_t)i * 64 * DM), (LAS unsigned*)(b + i * 8192), 16, 0, 0);
#pragma unroll
    for (int i = 0; i < 4; ++i) __builtin_amdgcn_global_load_lds((const unsigned*)(gW + (size_t)i * 64 * DM), (LAS unsigned*)(b + 32768 + i * 8192), 16, 0, 0);
}

__device__ __forceinline__ void g1_prefetch0(const bf16_t* __restrict__ Wt, const bf16_t* __restrict__ Xt, char* smem, int tid) {
    const int wv = __builtin_amdgcn_readfirstlane(tid >> 6), lane = tid & 63;
    LAS char* lds = (LAS char*)smem;
    const int sc = (lane & 7) ^ ((((wv & 1) << 2) + (lane >> 4)) & 7);
    const bf16_t* gX = Xt + (size_t)(wv * 8 + (lane >> 3)) * DM + sc * 8;
    const bf16_t* gW = Wt + (size_t)(wv * 8 + (lane >> 3)) * DM + sc * 8;
    LAS char* b = lds + wv * 1024;
#pragma unroll
    for (int i = 0; i < 4; ++i) __builtin_amdgcn_global_load_lds((const unsigned*)(gX + (size_t)i * 64 * DM), (LAS unsigned*)(b + i * 8192), 16, 0, 0);
#pragma unroll
    for (int i = 0; i < 2; ++i) __builtin_amdgcn_global_load_lds((const unsigned*)(gW + (size_t)i * 64 * DM), (LAS unsigned*)(b + 32768 + i * 8192), 16, 0, 0);
}

__device__ __forceinline__ void transpose_tile(const float* __restrict__ src, int ld_src, int ncols_valid, const float* __restrict__ gain, bf16_t* __restrict__ dst,
                               int k0, int e0, float* tile  , int tid) {
    __syncthreads();
    f32x4 v[4];
#pragma unroll
    for (int p = 0; p < 4; ++p) {
        const int k = p * 16 + (tid >> 5), e = (tid & 31) * 4;
        const float* s = src + (size_t)(k0 + k) * ld_src + e0 + e;
        if (e0 + e + 3 < ncols_valid) v[p] = __builtin_nontemporal_load((const f32x4*)s);
        else { v[p] = (f32x4){0.f, 0.f, 0.f, 0.f};
#pragma unroll
            for (int i = 0; i < 4; ++i) if (e0 + e + i < ncols_valid) v[p][i] = s[i]; }
    }
#pragma unroll
    for (int p = 0; p < 4; ++p) {
        const int k = p * 16 + (tid >> 5), e = (tid & 31) * 4;
        const float g = gain ? gain[k0 + k] : 1.0f;
        *(f32x4*)(tile + k * 132 + e) = v[p] * g;
    }
    __syncthreads();
#pragma unroll
    for (int p = 0; p < 2; ++p) {
        const int e = (tid >> 3) + 64 * p, c = (tid & 7) * 8;
        u32x4 o;
        o.x = pack_bf2(tile[(c + 0) * 132 + e], tile[(c + 1) * 132 + e]);
        o.y = pack_bf2(tile[(c + 2) * 132 + e], tile[(c + 3) * 132 + e]);
        o.z = pack_bf2(tile[(c + 4) * 132 + e], tile[(c + 5) * 132 + e]);
        o.w = pack_bf2(tile[(c + 6) * 132 + e], tile[(c + 7) * 132 + e]);
        *(u32x4*)(dst + (size_t)(e0 + e) * 1024 + k0 + c) = o;
    }
}
template <int MODE>
__device__ __forceinline__ void phase0(const Params& p, char* smem, int tid, int i0, int di) {
    asm volatile("" : "+v"(tid));
    const int wv = tid >> 6, lane = tid & 63;
    const int N_TIN = 16 * 26, N_TOUT = 16 * 8, N_WM = 32, N_ROWS = T_TOK / 32;
    const int total = MODE == 0 ? N_TIN + N_ROWS : N_TOUT + N_WM;
    for (int it0 = i0; it0 < total; it0 += di) {
        const int it = MODE == 0 ? (it0 < N_TIN ? it0 : it0 + N_TOUT + N_WM) : it0 + N_TIN;
        if (it < N_TIN) {
            const int kt = it & 15, et = it >> 4;
            transpose_tile(p.w_in, DIN, DIN, p.norm_gain, p.w.WinT, kt * 64, et * 128, (float*)smem, tid);
        } else if (it < N_TIN + N_TOUT) {
            const int t = it - N_TIN, kt = t & 15, et = t >> 4;
            transpose_tile(p.w_out, DM, DM, nullptr, p.w.WoutT, kt * 64, et * 128, (float*)smem, tid);
        } else if (it < N_TIN + N_TOUT + N_WM) {
            const int t = it - N_TIN - N_TOUT;
#pragma unroll
            for (int q = 0; q < 4; ++q) {
                const int e = t * 2048 + q * 512 + tid, i = (e >> 7) & 127, j = e & 127;
                const float v = ((j >> 6) <= (i >> 6)) ? p.sgu_w[e] : 0.f;
                p.w.Wm[e] = f2bf(v);
            }
        } else {
            const int row0 = (it - N_TIN - N_TOUT - N_WM) * 32 + wv * 4;
            f32x4 v[4][4];
#pragma unroll
            for (int r = 0; r < 4; ++r)
#pragma unroll
                for (int i = 0; i < 4; ++i) v[r][i] = __builtin_nontemporal_load((const f32x4*)(p.x + (size_t)(row0 + r) * DM + i * 256 + lane * 4));
#pragma unroll
            for (int r = 0; r < 4; ++r) {
                float s = 0.f;
#pragma unroll
                for (int i = 0; i < 4; ++i) s += v[r][i][0] * v[r][i][0] + v[r][i][1] * v[r][i][1] + v[r][i][2] * v[r][i][2] + v[r][i][3] * v[r][i][3];
                s = wave_sum(s);
                if (lane == 0) p.w.rinv[row0 + r] = rsqrtf(s * (1.0f / DM) + EPS);
#pragma unroll
                for (int i = 0; i < 4; ++i) {
                    u32x2 o; o.x = pack_bf2(v[r][i][0], v[r][i][1]); o.y = pack_bf2(v[r][i][2], v[r][i][3]);
                    *(u32x2*)(p.w.xb + (size_t)(row0 + r) * DM + i * 256 + lane * 4) = o;
                }
            }
        }
    }
}

__device__ __forceinline__ float quad_sum(float v) { v += __shfl_xor(v, 16); v += __shfl_xor(v, 32); return v; }

__device__ __forceinline__ void p1_unit(const Params& p, int tb, int ct, char* smem, int tid, int st0 = 0, int pre = 0, int ntb = -1, int nct = 0) {
    asm volatile("" : "+v"(tid));
    const int wv = tid >> 6, lane = tid & 63, wm = wv >> 2, wn = wv & 3, fr = lane & 15, fq = lane >> 4;
    float* st = (float*)(smem + ST_OFF);
    float rr[4];
#pragma unroll
    for (int ni = 0; ni < 4; ++ni) rr[ni] = p.w.rinv[tb * 256 + wn * 64 + ni * 16 + fr];
    f32x4 acc[4][4];
    gemm_ring(p.w.WinT + (size_t)ct * 128 * DM, p.w.xb + (size_t)tb * 256 * DM, smem, acc, tid, st0, pre,
              ntb >= 0 ? p.w.WinT + (size_t)nct * 128 * DM : nullptr, ntb >= 0 ? p.w.xb + (size_t)ntb * 256 * DM : nullptr);
    u32x2 ov[4][4];
    bf16_t* dtile = nullptr;
    if (ct >= 4 && ct < 8) {
#pragma unroll
        for (int ni = 0; ni < 4; ++ni) {
            float s1 = 0.f, s2 = 0.f;
#pragma unroll
            for (int mi = 0; mi < 4; ++mi)
#pragma unroll
                for (int i = 0; i < 4; ++i) { const float gvv = gelu_tanh(acc[mi][ni][i] * rr[ni]); acc[mi][ni][i] = gvv; s1 += gvv; s2 += gvv * gvv; }
            s1 = quad_sum(s1); s2 = quad_sum(s2);
            if (fq == 0) { const int tl = wn * 64 + ni * 16 + fr; st[(tl * 2 + wm) * 2 + 0] = s1; st[(tl * 2 + wm) * 2 + 1] = s2; }
            __builtin_amdgcn_sched_barrier(0);
        }
        __syncthreads();
#pragma unroll
        for (int ni = 0; ni < 4; ++ni) {
            const int tl = wn * 64 + ni * 16 + fr;
            const f32x4 sv = *(const f32x4*)(st + tl * 4);
            const float mu = (sv[0] + sv[2]) * (1.0f / 128.0f);
            const float var = (sv[1] + sv[3]) * (1.0f / 128.0f) - mu * mu;
            const float rs = rsqrtf(fmaxf(var, 0.f) + EPS);
#pragma unroll
            for (int mi = 0; mi < 4; ++mi) {
                const f32x4 gn = *(const f32x4*)(p.sgu_ng + (ct - 4) * 128 + wm * 64 + mi * 16 + fq * 4);
                ov[mi][ni].x = pack_bf2((acc[mi][ni][0] - mu) * rs * gn[0], (acc[mi][ni][1] - mu) * rs * gn[1]);
                ov[mi][ni].y = pack_bf2((acc[mi][ni][2] - mu) * rs * gn[2], (acc[mi][ni][3] - mu) * rs * gn[3]);
            }
            __builtin_amdgcn_sched_barrier(0);
        }
        dtile = p.w.vn + (size_t)tb * 256 * 512 + (ct - 4) * 128;
    } else {
#pragma unroll
        for (int ni = 0; ni < 4; ++ni) {
            const int tok = tb * 256 + wn * 64 + ni * 16 + fr;
            const float r = rr[ni];
            f32x4 v[4];
#pragma unroll
            for (int mi = 0; mi < 4; ++mi) v[mi] = acc[mi][ni] * r;
            if (ct < 4) {
#pragma unroll
                for (int mi = 0; mi < 4; ++mi) { ov[mi][ni].x = pack_bf2(gelu_tanh(v[mi][0]), gelu_tanh(v[mi][1])); ov[mi][ni].y = pack_bf2(gelu_tanh(v[mi][2]), gelu_tanh(v[mi][3])); }
            } else if (ct < 12 || (ct >= 17 && ct < 21)) {
#pragma unroll
                for (int mi = 0; mi < 4; ++mi) { ov[mi][ni].x = pack_bf2(silu_f(v[mi][0]), silu_f(v[mi][1])); ov[mi][ni].y = pack_bf2(silu_f(v[mi][2]), silu_f(v[mi][3])); }
            } else if (ct < 16 || (ct == 16 && wm == 0)) {
                float ss = 0.f;
#pragma unroll
                for (int mi = 0; mi < 4; ++mi) ss += v[mi][0] * v[mi][0] + v[mi][1] * v[mi][1] + v[mi][2] * v[mi][2] + v[mi][3] * v[mi][3];
                ss = quad_sum(ss);
                const bool isq = ct < 16;
                const float sc = rsqrtf(ss * (1.0f / 64.0f) + EPS) * (isq ? (0.125f * 1.4426950408889634f) : 1.0f);
                const float* gain = isq ? p.qg : p.kg;
#pragma unroll
                for (int mi = 0; mi < 4; ++mi) {
                    const int d = mi * 16 + fq * 4;
                    const f32x4 gv = *(const f32x4*)(gain + d);
                    u32x2 o; o.x = pack_bf2(v[mi][0] * sc * gv[0], v[mi][1] * sc * gv[1]); o.y = pack_bf2(v[mi][2] * sc * gv[2], v[mi][3] * sc * gv[3]);
                    if (isq) ov[mi][ni] = o; else *(u32x2*)(p.w.kn + (size_t)tok * 64 + d) = o;
                }
            } else if (ct == 16) {
                const int b = tok >> 11, pos = tok & 2047;
#pragma unroll
                for (int mi = 0; mi < 4; ++mi)
#pragma unroll
                    for (int i = 0; i < 4; ++i) p.w.vt[((size_t)b * 64 + mi * 16 + fq * 4 + i) * SEQ + vt_pos(pos)] = f2bf(v[mi][i]);
            } else if (ct < 25) {
#pragma unroll
                for (int mi = 0; mi < 4; ++mi) { ov[mi][ni].x = pack_bf2(v[mi][0], v[mi][1]); ov[mi][ni].y = pack_bf2(v[mi][2], v[mi][3]); }
            } else if (wm == 0) {
                float s1 = 0.f;
#pragma unroll
                for (int mi = 0; mi < 4; ++mi) s1 += v[mi][0] + v[mi][1] + v[mi][2] + v[mi][3];
                s1 = quad_sum(s1);
                const float mu = s1 * (1.0f / 64.0f);
                float s2 = 0.f;
#pragma unroll
                for (int mi = 0; mi < 4; ++mi) { v[mi] = v[mi] - mu; s2 += v[mi][0] * v[mi][0] + v[mi][1] * v[mi][1] + v[mi][2] * v[mi][2] + v[mi][3] * v[mi][3]; }
                s2 = quad_sum(s2);
                const float rs = rsqrtf(s2 * (1.0f / 64.0f) + EPS);
#pragma unroll
                for (int mi = 0; mi < 4; ++mi) {
                    const int d = mi * 16 + fq * 4;
                    const f32x4 gv = *(const f32x4*)(p.ikg + d);
                    u32x2 o; o.x = pack_bf2(v[mi][0] * rs * gv[0], v[mi][1] * rs * gv[1]); o.y = pack_bf2(v[mi][2] * rs * gv[2], v[mi][3] * rs * gv[3]);
                    *(u32x2*)(p.w.kin + (size_t)tok * 64 + d) = o;
                }
            } else {
                if (fq < 2) *(f32x4*)(p.w.wi + (size_t)tok * 8 + fq * 4) = v[0] * 0.04419417382415922f;
            }
            __builtin_amdgcn_sched_barrier(0);
        }
        if (ct < 4) dtile = p.w.gu + (size_t)tb * 256 * 512 + ct * 128;
        else if (ct < 12) dtile = p.w.gza + (size_t)tb * 256 * 512 + (ct - 8) * 128;
        else if (ct < 16) dtile = p.w.qn + (size_t)tb * 256 * 512 + (ct - 12) * 128;
        else if (ct >= 17 && ct < 21) dtile = p.w.gz + (size_t)tb * 256 * 512 + (ct - 17) * 128;
        else if (ct >= 21 && ct < 25) dtile = p.w.qi + (size_t)tb * 256 * 512 + (ct - 21) * 128;
    }
    if (dtile) {
        bf16_t* img = (bf16_t*)(smem + st0 * RING_STAGE);
        __syncthreads();
#pragma unroll
        for (int hf = 0; hf < 2; ++hf) {
            if ((wn >> 1) == hf) {
#pragma unroll
                for (int ni = 0; ni < 4; ++ni)
#pragma unroll
                    for (int mi = 0; mi < 4; ++mi) *(u32x2*)(img + ((wn & 1) * 64 + ni * 16 + fr) * 136 + wm * 64 + mi * 16 + fq * 4) = ov[mi][ni];
            }
            __syncthreads();
#pragma unroll
            for (int ps = 0; ps < 4; ++ps) {
                const int row = ps * 32 + (tid >> 4), ck = (tid & 15) * 8;
                const u32x4 t = *(const u32x4*)(img + row * 136 + ck);
                *(u32x4*)(dtile + (size_t)(hf * 128 + row) * 512 + ck) = t;
            }
            if (hf == 0) __syncthreads();
        }
    }
}

__device__ __forceinline__ void p1_unit256(const Params& p, int tb, int d, char* smem, int tid, bool pre, int ntb, int nd, int nstb, int nsct) {
    f32x4 acc[8][4];
    gemm_ring256(p.w.WinT + (size_t)d * 256 * DM, p.w.xb + (size_t)tb * 256 * DM, smem, acc, tid, pre);
    asm volatile("" : "+v"(tid));
    const int wv = tid >> 6, lane = tid & 63, wm = wv >> 2, wn = wv & 3, fr = lane & 15, fq = lane >> 4;
    const int ct = 2 * d + wm;
    float rr[4];
#pragma unroll
    for (int ni = 0; ni < 4; ++ni) rr[ni] = p.w.rinv[tb * 256 + wn * 64 + ni * 16 + fr];
    __syncthreads();
    if (ntb >= 0) g2_prefetch0(p.w.WinT + (size_t)nd * 256 * DM, p.w.xb + (size_t)ntb * 256 * DM, smem, tid);
    else if (nstb >= 0) g1_prefetch0(p.w.WinT + (size_t)nsct * 128 * DM, p.w.xb + (size_t)nstb * 256 * DM, smem, tid);
    bf16_t* dbase = ct < 4 ? p.w.gu + ct * 128 : ct < 8 ? p.w.vn + (ct - 4) * 128 : ct < 12 ? p.w.gza + (ct - 8) * 128 : ct < 16 ? p.w.qn + (ct - 12) * 128
                  : ct < 21 ? p.w.gz + (ct - 17) * 128 : p.w.qi + (ct - 21) * 128;
    bf16_t* img = (bf16_t*)(smem + 65536 + wv * 8704);
#pragma unroll
    for (int hf = 0; hf < 2; ++hf) {
#pragma unroll
    for (int n2 = 0; n2 < 2; ++n2) {
        const int ni = hf * 2 + n2;
        const int tok = tb * 256 + wn * 64 + ni * 16 + fr;
        const float r = rr[ni];
        bf16_t* dst = img + (n2 * 16 + fr) * 136 + fq * 4;
        f32x4 v[8];
#pragma unroll
        for (int mi = 0; mi < 8; ++mi) v[mi] = acc[mi][ni] * r;
        if (ct < 4) {
#pragma unroll
            for (int mi = 0; mi < 8; ++mi) { u32x2 o; o.x = pack_bf2(gelu_tanh(v[mi][0]), gelu_tanh(v[mi][1])); o.y = pack_bf2(gelu_tanh(v[mi][2]), gelu_tanh(v[mi][3])); *(u32x2*)(dst + mi * 16) = o; }
        } else if (ct < 8) {
            float s1 = 0.f, s2 = 0.f;
#pragma unroll
            for (int mi = 0; mi < 8; ++mi)
#pragma unroll
                for (int i = 0; i < 4; ++i) { const float gvv = gelu_tanh(v[mi][i]); v[mi][i] = gvv; s1 += gvv; s2 += gvv * gvv; }
            s1 = quad_sum(s1); s2 = quad_sum(s2);
            const float mu = s1 * (1.0f / 128.0f);
            const float rs = rsqrtf(fmaxf(s2 * (1.0f / 128.0f) - mu * mu, 0.f) + EPS);
#pragma unroll
            for (int mi = 0; mi < 8; ++mi) {
                const f32x4 gn = *(const f32x4*)(p.sgu_ng + (ct - 4) * 128 + mi * 16 + fq * 4);
                u32x2 o; o.x = pack_bf2((v[mi][0] - mu) * rs * gn[0], (v[mi][1] - mu) * rs * gn[1]); o.y = pack_bf2((v[mi][2] - mu) * rs * gn[2], (v[mi][3] - mu) * rs * gn[3]);
                *(u32x2*)(dst + mi * 16) = o;
            }
        } else if (ct < 12 || (ct >= 17 && ct < 21)) {
#pragma unroll
            for (int mi = 0; mi < 8; ++mi) { u32x2 o; o.x = pack_bf2(silu_f(v[mi][0]), silu_f(v[mi][1])); o.y = pack_bf2(silu_f(v[mi][2]), silu_f(v[mi][3])); *(u32x2*)(dst + mi * 16) = o; }
        } else if (ct < 16) {
#pragma unroll
            for (int hh = 0; hh < 2; ++hh) {
                float ss = 0.f;
#pragma unroll
                for (int m4 = 0; m4 < 4; ++m4) { const f32x4 t = v[hh * 4 + m4]; ss += t[0] * t[0] + t[1] * t[1] + t[2] * t[2] + t[3] * t[3]; }
                ss = quad_sum(ss);
                const float sc = rsqrtf(ss * (1.0f / 64.0f) + EPS) * (0.125f * 1.4426950408889634f);
#pragma unroll
                for (int m4 = 0; m4 < 4; ++m4) {
                    const f32x4 gv = *(const f32x4*)(p.qg + m4 * 16 + fq * 4); const f32x4 t = v[hh * 4 + m4];
                    u32x2 o; o.x = pack_bf2(t[0] * sc * gv[0], t[1] * sc * gv[1]); o.y = pack_bf2(t[2] * sc * gv[2], t[3] * sc * gv[3]);
                    *(u32x2*)(dst + (hh * 4 + m4) * 16) = o;
                }
            }
        } else if (ct == 16) {
            float ss = 0.f;
#pragma unroll
            for (int m4 = 0; m4 < 4; ++m4) { const f32x4 t = v[m4]; ss += t[0] * t[0] + t[1] * t[1] + t[2] * t[2] + t[3] * t[3]; }
            ss = quad_sum(ss);
            const float sc = rsqrtf(ss * (1.0f / 64.0f) + EPS);
#pragma unroll
            for (int m4 = 0; m4 < 4; ++m4) {
                const f32x4 gv = *(const f32x4*)(p.kg + m4 * 16 + fq * 4); const f32x4 t = v[m4];
                u32x2 o; o.x = pack_bf2(t[0] * sc * gv[0], t[1] * sc * gv[1]); o.y = pack_bf2(t[2] * sc * gv[2], t[3] * sc * gv[3]);
                *(u32x2*)(p.w.kn + (size_t)tok * 64 + m4 * 16 + fq * 4) = o;
            }
            const int b = tok >> 11, pos = tok & 2047;
#pragma unroll
            for (int m4 = 0; m4 < 4; ++m4)
#pragma unroll
                for (int i = 0; i < 4; ++i) p.w.vt[((size_t)b * 64 + m4 * 16 + fq * 4 + i) * SEQ + vt_pos(pos)] = f2bf(v[4 + m4][i]);
        } else {
#pragma unroll
            for (int mi = 0; mi < 8; ++mi) { u32x2 o; o.x = pack_bf2(v[mi][0], v[mi][1]); o.y = pack_bf2(v[mi][2], v[mi][3]); *(u32x2*)(dst + mi * 16) = o; }
        }
        __builtin_amdgcn_sched_barrier(0);
    }
    if (ct != 16) {
        bf16_t* grow = dbase + (size_t)(tb * 256 + wn * 64 + hf * 32) * 512;
#pragma unroll
        for (int ps = 0; ps < 8; ++ps) {
            const int row = ps * 4 + (lane >> 4), ck = (lane & 15) * 8;
            const u32x4 t = *(const u32x4*)(img + row * 136 + ck);
            *(u32x4*)(grow + (size_t)row * 512 + ck) = t;
        }
    }
    }
}

__device__ __forceinline__ void phase1(const Params& p, char* smem, int tid) {
    const int x = blockIdx.x & 7, li = blockIdx.x >> 3;
    const bool xaw = (opaque_grid() == 256);
    const int jlim = xaw ? 96 : 768, jst = xaw ? 32 : (int)gridDim.x;
    bool pre = false;
    for (int j = xaw ? li : (int)blockIdx.x; j < jlim; j += jst) {
        const int tb = xaw ? x + 8 * (4 * (j / 48) + (j & 3)) : j / 12, d = xaw ? (j % 48) / 4 : j % 12;
        const int jn = j + jst;
        const int ntb = jn < jlim ? (xaw ? x + 8 * (4 * (jn / 48) + (jn & 3)) : jn / 12) : -1, nd = xaw ? (jn % 48) / 4 : jn % 12;
        const int nstb = (xaw && ntb < 0 && li < 16) ? x + 8 * (li >> 1) : -1;
        p1_unit256(p, tb, d, smem, tid, pre, ntb, nd, nstb, 24 + (li & 1));
        pre = true;
    }
    for (int u = xaw ? (li < 16 ? li : 128) : (int)blockIdx.x; u < (xaw ? 16 : 128); u += xaw ? 128 : (int)gridDim.x)
        p1_unit(p, xaw ? x + 8 * (u >> 1) : u >> 1, 24 + (u & 1), smem, tid, 0, xaw ? 2 : 0);
    if (xaw) { if (li >= 16) phase0<1>(p, smem, tid, x * 16 + (li - 16), 128); }
    else phase0<1>(p, smem, tid, (int)blockIdx.x, (int)gridDim.x);
}

#define VNT_ROW 136
struct SguOps { u32x4 r[4]; bf16x8 bw[4][2]; u32x2 guv[2][4], zv[2][4]; float bi[2]; };
__device__ __forceinline__ void sgu_load(const Params& p, int nb, int g, int tid, SguOps& o) {
    const int wv = tid >> 6, lane = tid & 63, wm = wv >> 2, wn = wv & 3, fr = lane & 15, fq = lane >> 4;
    const int j = tid >> 2, c0 = (tid & 3) * 32;
    {
        const bf16_t* src = p.w.vn + (size_t)(nb * 128 + j) * 512 + g * 128 + c0;
#pragma unroll
        for (int q = 0; q < 4; ++q) o.r[q] = *(const u32x4*)(src + q * 8);
    }
    const bf16_t* Wg = p.w.Wm + (size_t)g * 128 * 128;
#pragma unroll
    for (int ks = 0; ks < 4; ++ks)
#pragma unroll
        for (int i = 0; i < 2; ++i) o.bw[ks][i] = *(const bf16x8*)(Wg + (size_t)(wn * 32 + i * 16 + fr) * 128 + ks * 32 + fq * 8);
#pragma unroll
    for (int ni = 0; ni < 2; ++ni) {
        const int tl = wn * 32 + ni * 16 + fr;
        o.bi[ni] = p.sgu_b[g * 128 + tl];
#pragma unroll
        for (int mi = 0; mi < 4; ++mi) {
            const size_t off = (size_t)(nb * 128 + tl) * 512 + g * 128 + wm * 64 + mi * 16 + fq * 4;
            o.guv[ni][mi] = *(const u32x2*)(p.w.gu + off);
            o.zv[ni][mi] = *(const u32x2*)(p.w.gza + off);
        }
    }
}
template <bool NEXT>
__device__ __forceinline__ void sgu_compute(const Params& p, int nb, int g, char* smem, int tid, SguOps& o, int nnb, int ng, SguOps& nx) {
    const int wv = tid >> 6, lane = tid & 63, wm = wv >> 2, wn = wv & 3, fr = lane & 15, fq = lane >> 4;
    bf16_t* vnT = (bf16_t*)smem;
    float* st = (float*)(smem + 36864);
    const int j = tid >> 2, c0 = (tid & 3) * 32;
    __syncthreads();
#pragma unroll
    for (int q = 0; q < 4; ++q) {
        const unsigned wds[4] = {o.r[q].x, o.r[q].y, o.r[q].z, o.r[q].w};
#pragma unroll
        for (int e = 0; e < 4; ++e) {
            vnT[(c0 + q * 8 + 2 * e) * VNT_ROW + j] = (bf16_t)(wds[e] & 0xffffu);
            vnT[(c0 + q * 8 + 2 * e + 1) * VNT_ROW + j] = (bf16_t)(wds[e] >> 16);
        }
    }
    __syncthreads();
    if (NEXT) sgu_load(p, nnb, ng, tid, nx);
    f32x4 gnv[4];
#pragma unroll
    for (int mi = 0; mi < 4; ++mi) gnv[mi] = *(const f32x4*)(p.bng + g * 128 + wm * 64 + mi * 16 + fq * 4);
    f32x4 sacc[4][2];
#pragma unroll
    for (int mi = 0; mi < 4; ++mi) { sacc[mi][0] = (f32x4){0.f, 0.f, 0.f, 0.f}; sacc[mi][1] = (f32x4){0.f, 0.f, 0.f, 0.f}; }
#pragma unroll
    for (int ks = 0; ks < 4; ++ks) {
        bf16x8 a[4];
#pragma unroll
        for (int i = 0; i < 4; ++i) a[i] = *(const bf16x8*)(vnT + (wm * 64 + i * 16 + fr) * VNT_ROW + ks * 32 + fq * 8);
#pragma unroll
        for (int mi = 0; mi < 4; ++mi)
#pragma unroll
            for (int ni = 0; ni < 2; ++ni) sacc[mi][ni] = __builtin_amdgcn_mfma_f32_16x16x32_bf16(a[mi], o.bw[ks][ni], sacc[mi][ni], 0, 0, 0);
    }
#pragma unroll
    for (int ni = 0; ni < 2; ++ni) {
        const int tl = wn * 32 + ni * 16 + fr;
        float s2 = 0.f;
#pragma unroll
        for (int mi = 0; mi < 4; ++mi) {
            const u32x2 gv = o.guv[ni][mi];
            const float y0 = bf_lo(gv.x) * (sacc[mi][ni][0] + o.bi[ni]), y1 = bf_hi(gv.x) * (sacc[mi][ni][1] + o.bi[ni]);
            const float y2 = bf_lo(gv.y) * (sacc[mi][ni][2] + o.bi[ni]), y3 = bf_hi(gv.y) * (sacc[mi][ni][3] + o.bi[ni]);
            sacc[mi][ni] = (f32x4){y0, y1, y2, y3};
            s2 += y0 * y0 + y1 * y1 + y2 * y2 + y3 * y3;
        }
        s2 = quad_sum(s2);
        if (fq == 0) st[tl * 2 + wm] = s2;
    }
    __syncthreads();
#pragma unroll
    for (int ni = 0; ni < 2; ++ni) {
        const int tl = wn * 32 + ni * 16 + fr, tok = nb * 128 + tl;
        const float rs = rsqrtf((st[tl * 2] + st[tl * 2 + 1]) * (1.0f / 128.0f) + EPS);
#pragma unroll
        for (int mi = 0; mi < 4; ++mi) {
            const int ch = g * 128 + wm * 64 + mi * 16 + fq * 4;
            const f32x4 gn = gnv[mi];
            const u32x2 zz = o.zv[ni][mi];
            u32x2 ov;
            ov.x = pack_bf2(sacc[mi][ni][0] * rs * gn[0] * bf_lo(zz.x), sacc[mi][ni][1] * rs * gn[1] * bf_hi(zz.x));
            ov.y = pack_bf2(sacc[mi][ni][2] * rs * gn[2] * bf_lo(zz.y), sacc[mi][ni][3] * rs * gn[3] * bf_hi(zz.y));
            *(u32x2*)(p.w.mixed + (size_t)tok * 1024 + ch) = ov;
        }
    }
}

__device__ __forceinline__ void phase_sgu(const Params& p, char* smem, int tid) {
    asm volatile("" : "+v"(tid));
    const int x = blockIdx.x & 7, li = blockIdx.x >> 3;
    const bool xaw = (opaque_grid() == 256);
    if (xaw) {
        const int it = 2 * li, nb = 2 * (x + 8 * (it >> 3)) + ((it >> 2) & 1), g = it & 3;
        SguOps o0, o1;
        sgu_load(p, nb, g, tid, o0);
        sgu_compute<true>(p, nb, g, smem, tid, o0, nb, g + 1, o1);
        sgu_compute<false>(p, nb, g + 1, smem, tid, o1, 0, 0, o0);
    } else {
        for (int it = (int)blockIdx.x; it < 512; it += (int)gridDim.x) {
            SguOps o0;
            sgu_load(p, it >> 2, it & 3, tid, o0);
            sgu_compute<false>(p, it >> 2, it & 3, smem, tid, o0, 0, 0, o0);
        }
    }
}

#define LOG2E 1.4426950408889634f
__device__ __forceinline__ unsigned mono_key(float f) { const unsigned u = __float_as_uint(f); return u ^ ((unsigned)((int)u >> 31) | 0x80000000u); }
__device__ __forceinline__ int half_sum_i(int v) { v += __shfl_xor(v, 16); v += __shfl_xor(v, 8); v += __shfl_xor(v, 4); v += __shfl_xor(v, 2); v += __shfl_xor(v, 1); return v; }
__device__ __forceinline__ float half_min_f(float v) { v = fminf(v, __shfl_xor(v, 16)); v = fminf(v, __shfl_xor(v, 8)); v = fminf(v, __shfl_xor(v, 4)); v = fminf(v, __shfl_xor(v, 2)); v = fminf(v, __shfl_xor(v, 1)); return v; }

__device__ __forceinline__ void p2_item(const Params& p, int b, int qt, char* smem, int tid) {
    asm volatile("" : "+v"(tid));
    bf16_t* sK = (bf16_t*)smem;
    bf16_t* sV = sK + 2 * 64 * LROW;
    unsigned* maskL = (unsigned*)(smem + 36864);
    float* dnearL = (float*)(smem + 36864 + 8192);
    const int wv = tid >> 6, lane = tid & 63, G = lane >> 5, n = lane & 31;
    const int c = qt >> 1, nsteps = c + 1, ntiles = 2 * nsteps;
    const int tok0 = b * SEQ + qt * 32, pos0 = qt * 32;
    const int srow = tid >> 3, sch = (tid & 7) * 8;
    unsigned* mw_wave = maskL + wv * 256;
    __syncthreads();
    const int ql = n >> 3, h = n & 7;
    bf16x8 qfr[4]; u32x4 rk0, rv0; u32x2 gzp[2][4];
    const bf16_t* ksrc = p.w.kn + ((size_t)b * SEQ + srow) * 64 + sch;
    const bf16_t* vsrc = p.w.vt + ((size_t)b * 64 + srow) * SEQ + sch;
#define P2_PREFETCH() do { \
        const bf16_t* _qs = p.w.qn + (size_t)(tok0 + 4 * wv + ql) * 512 + h * 64 + 8 * G; \
        _Pragma("unroll") for (int _s = 0; _s < 4; ++_s) qfr[_s] = *(const bf16x8*)(_qs + 16 * _s); \
        rk0 = *(const u32x4*)(ksrc); rv0 = *(const u32x4*)(vsrc); } while (0)
    if (nsteps > 4) {
        bf16x8 afr[4];
        {
            const int ql = 2 * ((n >> 2) & 1) + (n >> 4), hd = 4 * ((n >> 3) & 1) + (n & 3);
            const bf16_t* src = p.w.qi + (size_t)(tok0 + 4 * wv + ql) * 512 + hd * 64 + 8 * G;
#pragma unroll
            for (int s = 0; s < 4; ++s) afr[s] = *(const bf16x8*)(src + 16 * s);
        }
        float w[16];
        {
            const float* wsrc = p.w.wi + (size_t)(tok0 + 4 * wv + 2 * G) * 8;
#pragma unroll
            for (int q4 = 0; q4 < 4; ++q4) { const f32x4 t = *(const f32x4*)(wsrc + 4 * q4); w[4 * q4] = t[0]; w[4 * q4 + 1] = t[1]; w[4 * q4 + 2] = t[2]; w[4 * q4 + 3] = t[3]; }
        }
        unsigned kk[128];
#pragma unroll
        for (int i = 0; i < 128; ++i) kk[i] = 0u;
        {
        const bf16_t* kisrc = p.w.kin + ((size_t)b * SEQ + srow) * 64 + sch;
        const bf16_t* kip = kisrc;
        u32x4 r0 = *(const u32x4*)(kisrc);
        *(u32x4*)(sK + srow * LROW + sch) = r0;
        __syncthreads();
#pragma unroll
        for (int st = 0; st < 32; ++st) {
            if (st < nsteps) {
                const bf16_t* buf = sK + (st & 1) * 64 * LROW;
                if (st + 1 < nsteps) {
                    kip += 64 * 64; asm volatile("" : "+v"(kip));
                    r0 = *(const u32x4*)(kip);
                }
                unsigned kq[2][2];
#pragma unroll
                for (int kt = 0; kt < 2; ++kt) {
                    f32x16 D;
#pragma unroll
                    for (int k = 0; k < 16; ++k) D[k] = 0.f;
#pragma unroll
                    for (int s = 0; s < 4; ++s) {
                        const bf16x8 bfr = *(const bf16x8*)(buf + (kt * 32 + n) * LROW + 16 * s + 8 * G);
                        D = __builtin_amdgcn_mfma_f32_32x32x16_bf16(afr[s], bfr, D, 0, 0, 0);
                    }
                    float s0 = 0.f, s1 = 0.f;
#pragma unroll
                    for (int k = 0; k < 8; ++k) {
                        const float r0 = __int_as_float(max(__float_as_int(D[k]), 0)), r1 = __int_as_float(max(__float_as_int(D[8 + k]), 0));
                        s0 = fmaf(w[k], r0, s0); s1 = fmaf(w[8 + k], r1, s1);
                    }
                    unsigned k0v = mono_key(s0), k1v = mono_key(s1);
                    asm volatile("" : "+v"(k0v), "+v"(k1v));
                    kq[kt][0] = k0v; kq[kt][1] = k1v;
                    __builtin_amdgcn_sched_barrier(0);
                }
#pragma unroll
                for (int a = 0; a < 2; ++a) {
                    const auto sw = __builtin_amdgcn_permlane32_swap(kq[0][a], kq[1][a], false, false);
                    kk[a * 32 + st] = sw[0];
                    kk[(2 + a) * 32 + st] = sw[1];
                }
                if (st + 1 < nsteps) {
                    bf16_t* nb = sK + ((st + 1) & 1) * 64 * LROW;
                    *(u32x4*)(nb + srow * LROW + sch) = r0;
                }
                __syncthreads();
            }
        }
        }
        P2_PREFETCH();
        {
#define SEL_COUNT(cand_, cnt_) do { unsigned a0_ = 0u, a1_ = 0u; \
            _Pragma("unroll") for (int g8 = 0; g8 < 4; ++g8) { if (g8 * 8 < nsteps) { \
                unsigned long long bm[8]; \
                asm volatile("v_cmp_ge_u32_e64 %2, %10, %18\n\tv_cmp_ge_u32_e64 %3, %11, %18\n\tv_cmp_ge_u32_e64 %4, %12, %18\n\tv_cmp_ge_u32_e64 %5, %13, %18\n\t" \
                             "v_cmp_ge_u32_e64 %6, %14, %18\n\tv_cmp_ge_u32_e64 %7, %15, %18\n\tv_cmp_ge_u32_e64 %8, %16, %18\n\tv_cmp_ge_u32_e64 %9, %17, %18\n\t" \
                             "v_addc_co_u32_e64 %0, %2, %0, 0, %2\n\tv_addc_co_u32_e64 %1, %3, %1, 0, %3\n\tv_addc_co_u32_e64 %0, %4, %0, 0, %4\n\tv_addc_co_u32_e64 %1, %5, %1, 0, %5\n\t" \
                             "v_addc_co_u32_e64 %0, %6, %0, 0, %6\n\tv_addc_co_u32_e64 %1, %7, %1, 0, %7\n\tv_addc_co_u32_e64 %0, %8, %0, 0, %8\n\tv_addc_co_u32_e64 %1, %9, %1, 0, %9" \
                             : "+v"(a0_), "+v"(a1_), "=&s"(bm[0]), "=&s"(bm[1]), "=&s"(bm[2]), "=&s"(bm[3]), "=&s"(bm[4]), "=&s"(bm[5]), "=&s"(bm[6]), "=&s"(bm[7]) \
                             : "v"(kk[q * 32 + g8 * 8 + 0]), "v"(kk[q * 32 + g8 * 8 + 1]), "v"(kk[q * 32 + g8 * 8 + 2]), "v"(kk[q * 32 + g8 * 8 + 3]), \
                               "v"(kk[q * 32 + g8 * 8 + 4]), "v"(kk[q * 32 + g8 * 8 + 5]), "v"(kk[q * 32 + g8 * 8 + 6]), "v"(kk[q * 32 + g8 * 8 + 7]), "v"(cand_)); } } \
            unsigned s_ = a0_ + a1_; \
            s_ += (unsigned)__builtin_amdgcn_update_dpp(0, (int)s_, 0x111, 0xf, 0xf, true); \
            s_ += (unsigned)__builtin_amdgcn_update_dpp(0, (int)s_, 0x112, 0xf, 0xf, true); \
            s_ += (unsigned)__builtin_amdgcn_update_dpp(0, (int)s_, 0x114, 0xf, 0xf, true); \
            s_ += (unsigned)__builtin_amdgcn_update_dpp(0, (int)s_, 0x118, 0xf, 0xf, true); \
            s_ += (unsigned)__builtin_amdgcn_update_dpp(0, (int)s_, 0x142, 0xa, 0xf, true); \
            s_ += (unsigned)__builtin_amdgcn_update_dpp(0, (int)s_, 0x143, 0xc, 0xf, true); \
            cnt_ = __builtin_amdgcn_readlane((int)s_, 63); } while (0)
#pragma unroll
        for (int q = 0; q < 4; ++q) {
            unsigned T = 0u; bool exact = false; int bit = 30, cnt;
            { const unsigned c0 = 0x80000000u; SEL_COUNT(c0, cnt); }
            if (cnt >= 256) {
                T = 0x80000000u; exact = (cnt == 256);
                if (!exact) {
                    unsigned mx = 0u;
#pragma unroll
                    for (int g8 = 0; g8 < 4; ++g8) {
                        if (g8 * 8 < nsteps) {
#pragma unroll
                            for (int j = 0; j < 8; ++j) mx = max(mx, kk[q * 32 + g8 * 8 + j]);
                        }
                    }
                    mx = max(mx, (unsigned)__builtin_amdgcn_update_dpp(0, (int)mx, 0x111, 0xf, 0xf, true));
                    mx = max(mx, (unsigned)__builtin_amdgcn_update_dpp(0, (int)mx, 0x112, 0xf, 0xf, true));
                    mx = max(mx, (unsigned)__builtin_amdgcn_update_dpp(0, (int)mx, 0x114, 0xf, 0xf, true));
                    mx = max(mx, (unsigned)__builtin_amdgcn_update_dpp(0, (int)mx, 0x118, 0xf, 0xf, true));
                    mx = max(mx, (unsigned)__builtin_amdgcn_update_dpp(0, (int)mx, 0x142, 0xa, 0xf, true));
                    mx = max(mx, (unsigned)__builtin_amdgcn_update_dpp(0, (int)mx, 0x143, 0xc, 0xf, true));
                    unsigned e = (unsigned)__builtin_amdgcn_readlane((int)mx, 63) >> 23;
                    for (int tries = 0; tries < 8 && e > 0x100u; ++tries, --e) {
                        const unsigned cand = e << 23;
                        SEL_COUNT(cand, cnt);
                        if (cnt >= 256) { T = cand; exact = (cnt == 256); bit = 22; break; }
                    }
                }
            }
            for (; bit >= 0 && !exact; --bit) {
                const unsigned cand = T | (1u << bit);
                SEL_COUNT(cand, cnt);
                if (cnt >= 256) T = cand;
                if (cnt == 256) exact = true;
            }
            unsigned mrow = 0u;
            if (exact) {
#pragma unroll
                for (int g4 = 0; g4 < 8; ++g4) {
                    if (g4 * 4 < nsteps) {
#pragma unroll
                        for (int j = 0; j < 4; ++j) {
                            const int pp = g4 * 4 + j;
                            const unsigned long long sb = __ballot(kk[q * 32 + pp] >= T);
                            asm volatile("s_nop 1\n\tv_writelane_b32 %0, %1, %3\n\tv_writelane_b32 %0, %2, %4" : "+v"(mrow) : "s"((unsigned)sb), "s"((unsigned)(sb >> 32)), "n"(2 * pp), "n"(2 * pp + 1));
                        }
                    }
                }
            } else {
                int cg = 0;
#pragma unroll
                for (int g4 = 0; g4 < 8; ++g4) {
                    if (g4 * 4 < nsteps) {
#pragma unroll
                        for (int j = 0; j < 4; ++j) cg += __builtin_popcountll(__ballot(kk[q * 32 + g4 * 4 + j] > T));
                    }
                }
                const int need = 256 - cg;
                int run = 0;
#pragma unroll
                for (int g4 = 0; g4 < 8; ++g4) {
                    if (g4 * 4 < nsteps) {
#pragma unroll
                        for (int j = 0; j < 4; ++j) {
                            const int pp = g4 * 4 + j;
                            const unsigned key = kk[q * 32 + pp];
                            const bool eq = key == T;
                            const unsigned long long eb = __ballot(eq);
                            const int rank = run + (int)__builtin_amdgcn_mbcnt_hi((unsigned)(eb >> 32), __builtin_amdgcn_mbcnt_lo((unsigned)eb, 0u));
                            run += __builtin_popcountll(eb);
                            const unsigned long long sb = __ballot((key > T) || (eq && rank < need));
                            asm volatile("s_nop 1\n\tv_writelane_b32 %0, %1, %3\n\tv_writelane_b32 %0, %2, %4" : "+v"(mrow) : "s"((unsigned)sb), "s"((unsigned)(sb >> 32)), "n"(2 * pp), "n"(2 * pp + 1));
                        }
                    }
                }
            }
            mw_wave[q * 64 + lane] = mrow;
            const unsigned bits = mrow;
            const int qp = pos0 + 4 * wv + q, wq = qp >> 5, bq = qp & 31;
            const unsigned lo_m = (lane < wq) ? bits : ((lane == wq) ? (bits & (0xffffffffu >> (31 - bq))) : 0u);
            const unsigned hi_m = (lane > wq) ? bits : ((lane == wq) ? (bits & (0xffffffffu << bq)) : 0u);
            float d = 1e9f;
            if (lo_m) d = (float)(qp - (32 * lane + 31 - __clz((int)lo_m)));
            if (hi_m) d = fminf(d, (float)(32 * lane + (__ffs((int)hi_m) - 1) - qp));
            d = fminf(d, __shfl_xor(d, 32)); d = half_min_f(d);
            if (lane == 0) dnearL[wv * 4 + q] = d;
        }
#undef SEL_COUNT
        }
    } else {
        P2_PREFETCH();
        for (int i = lane; i < 256; i += 64) mw_wave[i] = ((i & 63) < ntiles) ? 0xffffffffu : 0u;
        if (lane < 4) dnearL[wv * 4 + lane] = 0.f;
    }
    const float slope2 = exp2f(-(float)(h + 1)) * LOG2E;
    const float qposf = (float)(pos0 + 4 * wv + ql);
    f32x16 o0, o1, ol; float l = 0.f, dn = 0.f;
#pragma unroll
    for (int dt = 0; dt < 2; ++dt)
#pragma unroll
        for (int kq = 0; kq < 4; ++kq) gzp[dt][kq] = *(const u32x2*)(p.w.gz + (size_t)(tok0 + 4 * wv + ql) * 512 + h * 64 + dt * 32 + 8 * kq + 4 * G);
    bf16x8 ones;
#pragma unroll
    for (int k = 0; k < 8; ++k) ones[k] = (short)0x3f80;
    {
    __syncthreads();
    dn = dnearL[wv * 4 + ql];
    *(u32x4*)(sK + srow * LROW + sch) = rk0;
    *(u32x4*)(sV + srow * LROW + sch) = rv0;
    __syncthreads();
#pragma unroll
    for (int k = 0; k < 16; ++k) { o0[k] = 0.f; o1[k] = 0.f; ol[k] = 0.f; }
    l = 0.f;
    for (int st = 0; st < nsteps; ++st) {
        const bf16_t* bK = sK + (st & 1) * 64 * LROW;
        const bf16_t* bV = sV + (st & 1) * 64 * LROW;
        if (st + 1 < nsteps) {
            rk0 = *(const u32x4*)(ksrc + (size_t)(st + 1) * 64 * 64);
            rv0 = *(const u32x4*)(vsrc + (st + 1) * 64);
        }
#pragma unroll
        for (int kt = 0; kt < 2; ++kt) {
            const unsigned mwsh = mw_wave[ql * 64 + 2 * st + kt] >> (4 * G);
            const float kb = (float)(st * 64 + kt * 32 + 4 * G);
            f32x16 D;
            if (st < c) {
                const float e = slope2 * (kb - qposf + dn);
#pragma unroll
                for (int k = 0; k < 16; ++k) D[k] = fmaf(slope2, (float)((k & 3) + 8 * (k >> 2)), e);
            } else {
#pragma unroll
                for (int k = 0; k < 16; ++k) D[k] = -slope2 * (fabsf(qposf - kb - (float)((k & 3) + 8 * (k >> 2))) - dn);
            }
#pragma unroll
            for (int s = 0; s < 4; ++s) {
                const bf16x8 kfr = *(const bf16x8*)(bK + (kt * 32 + n) * LROW + 16 * s + 8 * G);
                D = __builtin_amdgcn_mfma_f32_32x32x16_bf16(kfr, qfr[s], D, 0, 0, 0);
            }
            unsigned pk[8];
#pragma unroll
            for (int k2 = 0; k2 < 8; ++k2) {
                float pe[2];
#pragma unroll
                for (int u = 0; u < 2; ++u) {
                    const int k = 2 * k2 + u, ck = (k & 3) + 8 * (k >> 2);
                    const float e = __builtin_amdgcn_exp2f(D[k]);
                    const int m = __builtin_amdgcn_sbfe((int)mwsh, ck, 1);
                    pe[u] = __uint_as_float(__float_as_uint(e) & (unsigned)m);
                }
                pk[k2] = pack_bf2(pe[0], pe[1]);
            }
            bf16x8 pf[2];
#pragma unroll
            for (int ks = 0; ks < 2; ++ks) {
                u32x4 t; t.x = pk[4 * ks]; t.y = pk[4 * ks + 1]; t.z = pk[4 * ks + 2]; t.w = pk[4 * ks + 3];
                pf[ks] = __builtin_bit_cast(bf16x8, t);
            }
#pragma unroll
            for (int ks = 0; ks < 2; ++ks) {
                const bf16x8 v0 = *(const bf16x8*)(bV + n * LROW + (2 * kt + ks) * 16 + 8 * G);
                const bf16x8 v1 = *(const bf16x8*)(bV + (32 + n) * LROW + (2 * kt + ks) * 16 + 8 * G);
                o0 = __builtin_amdgcn_mfma_f32_32x32x16_bf16(v0, pf[ks], o0, 0, 0, 0);
                o1 = __builtin_amdgcn_mfma_f32_32x32x16_bf16(v1, pf[ks], o1, 0, 0, 0);
                ol = __builtin_amdgcn_mfma_f32_32x32x16_bf16(ones, pf[ks], ol, 0, 0, 0);
            }
        }
        if (st + 1 < nsteps) {
            bf16_t* nK = sK + ((st + 1) & 1) * 64 * LROW; bf16_t* nV = sV + ((st + 1) & 1) * 64 * LROW;
            *(u32x4*)(nK + srow * LROW + sch) = rk0;
            *(u32x4*)(nV + srow * LROW + sch) = rv0;
        }
        __syncthreads();
    }
    }
    l = ol[0];
    const float il = 1.0f / l;
    float ss = 0.f;
#pragma unroll
    for (int k = 0; k < 16; ++k) { o0[k] *= il; o1[k] *= il; ss += o0[k] * o0[k] + o1[k] * o1[k]; }
    ss += __shfl_xor(ss, 32);
    const float rs = rsqrtf(ss * (1.0f / 64.0f) + EPS);
    bf16_t* oimg = (bf16_t*)(smem + 49152) + wv * (4 * 8 * 72);
#pragma unroll
    for (int dt = 0; dt < 2; ++dt)
#pragma unroll
        for (int kq = 0; kq < 4; ++kq) {
            const int d0 = dt * 32 + 8 * kq + 4 * G;
            const f32x4 gn = *(const f32x4*)(p.bng + 512 + h * 64 + d0);
            const u32x2 gzv = gzp[dt][kq];
            const float z0 = __uint_as_float(gzv.x << 16), z1 = __uint_as_float(gzv.x & 0xffff0000u), z2 = __uint_as_float(gzv.y << 16), z3 = __uint_as_float(gzv.y & 0xffff0000u);
            const float y0 = (dt ? o1[4 * kq] : o0[4 * kq]) * rs * gn[0] * z0, y1 = (dt ? o1[4 * kq + 1] : o0[4 * kq + 1]) * rs * gn[1] * z1;
            const float y2 = (dt ? o1[4 * kq + 2] : o0[4 * kq + 2]) * rs * gn[2] * z2, y3 = (dt ? o1[4 * kq + 3] : o0[4 * kq + 3]) * rs * gn[3] * z3;
            u32x2 o; o.x = pack_bf2(y0, y1); o.y = pack_bf2(y2, y3);
            *(u32x2*)(oimg + (ql * 8 + h) * 72 + d0) = o;
        }
#pragma unroll
    for (int q = 0; q < 4; ++q) {
        const u32x4 t = *(const u32x4*)(oimg + (q * 8 + (lane >> 3)) * 72 + (lane & 7) * 8);
        *(u32x4*)(p.w.mixed + (size_t)(tok0 + 4 * wv + q) * 1024 + 512 + lane * 8) = t;
    }
}

__device__ __forceinline__ void phase2(const Params& p, char* smem, int tid) {
    const int Gn = gridDim.x, bi = blockIdx.x;
    for (int rd = 0;; ++rd) {
        const int rank = rd * Gn + ((rd & 1) ? (Gn - 1 - bi) : bi);
        if (rank >= 512) break;
        const int c = 31 - (rank >> 4), j = rank & 15;
        p2_item(p, j >> 1, c * 2 + (j & 1), smem, tid);
    }
}

__device__ __forceinline__ void phase3(const Params& p, char* smem, int tid) {
    const bool xaw = (opaque_grid() == 256);
    for (int r = 0;; ++r) {
        int u;
        if (xaw) { if (r) break; u = ((blockIdx.x & 7) + 8 * (blockIdx.x >> 5)) * 4 + ((blockIdx.x >> 3) & 3); }
        else { u = blockIdx.x + r * gridDim.x; if (u >= 256) break; }
        const int tb = u >> 2, cb = u & 3;
        f32x4 acc[8][4];
        gemm_ring256(p.w.WoutT + (size_t)cb * 256 * DM, p.w.mixed + (size_t)tb * 256 * DM, smem, acc, tid);
        asm volatile("" : "+v"(tid));
        const int wv = tid >> 6, lane = tid & 63, wm = wv >> 2, wn = wv & 3, fr = lane & 15, fq = lane >> 4;
        float* img = (float*)(smem + wv * 16896);
        __syncthreads();
        const size_t gbase = (size_t)(tb * 256 + wn * 64) * DM + cb * 256 + wm * 128 + (lane & 31) * 4;
#pragma unroll
        for (int hf = 0; hf < 2; ++hf) {
#pragma unroll
            for (int n2 = 0; n2 < 2; ++n2)
#pragma unroll
                for (int mi = 0; mi < 8; ++mi) *(f32x4*)(img + (n2 * 16 + fr) * 132 + mi * 16 + fq * 4) = acc[mi][hf * 2 + n2];
#pragma unroll
            for (int bt = 0; bt < 2; ++bt) {
                f32x4 xv[8];
#pragma unroll
                for (int ps = 0; ps < 8; ++ps) {
                    const int row = (bt * 8 + ps) * 2 + (lane >> 5);
                    xv[ps] = __builtin_nontemporal_load((const f32x4*)(p.x + gbase + (size_t)(hf * 32 + row) * DM));
                }
#pragma unroll
                for (int ps = 0; ps < 8; ++ps) {
                    const int row = (bt * 8 + ps) * 2 + (lane >> 5);
                    const f32x4 t = *(const f32x4*)(img + row * 132 + (lane & 31) * 4);
                    __builtin_nontemporal_store(xv[ps] + t, (f32x4*)(p.out + gbase + (size_t)(hf * 32 + row) * DM));
                }
            }
        }
    }
}

#define XB_TMO      128
#define XB_XCNT(j)  (256  + 64 * (j))
#define XB_XSUB(j)  (1280 + 64 * (j))
#define XB_XGEN(j)  (2304 + 64 * (j))
#define XB_TOP      3328
#define XB_TOPGEN   3392
#define XCD_BAR_WORDS 3456
#define XB_SPIN_CAP (1u << 18)
#define XLAS __attribute__((address_space(3)))
__device__ __forceinline__ unsigned xb_ld(unsigned* p)              { return __hip_atomic_load(p, __ATOMIC_RELAXED, __HIP_MEMORY_SCOPE_AGENT); }
__device__ __forceinline__ unsigned xb_add(unsigned* p, unsigned v) { return __hip_atomic_fetch_add(p, v, __ATOMIC_RELAXED, __HIP_MEMORY_SCOPE_AGENT); }
__device__ __forceinline__ unsigned xb_xcc_id() { return (unsigned)__builtin_amdgcn_s_getreg((3 << 11) | 20) & 0xFu; }
#define XB_SPIN(cond, bar) do { unsigned _sp = 0; while (cond) { __builtin_amdgcn_s_sleep(1); \
    if ((++_sp & 255u) == 0u) { if (xb_ld(&(bar)[XB_TMO])) break; if (_sp > XB_SPIN_CAP) { atomicAdd(&(bar)[XB_TMO], 1u); break; } } } } while (0)
struct XcdBarrier { unsigned* bar; unsigned x; volatile XLAS unsigned* st; };
__device__ __forceinline__ XcdBarrier xcd_barrier_post(unsigned* bar, volatile XLAS unsigned* st) {
    XcdBarrier b; b.bar = bar; b.x = xb_xcc_id(); b.st = st;
    if (threadIdx.x == 0) (void)xb_add(&bar[XB_XCNT(b.x)], 1u);
    return b;
}
__device__ __forceinline__ void xcd_barrier_complete(unsigned* bar, unsigned x, unsigned& nloc, unsigned& nx) {
    const unsigned G = gridDim.x * gridDim.y * gridDim.z;
    unsigned sum, cnt, mine, sp = 0u;
    for (;;) {
        sum = 0u; cnt = 0u; mine = 0u;
#pragma unroll
        for (unsigned j = 0; j < 16; ++j) { const unsigned c = xb_ld(&bar[XB_XCNT(j)]); sum += c; cnt += (c > 0u) ? 1u : 0u; mine = (j == x) ? c : mine; }
        if (sum == G) break;
        __builtin_amdgcn_s_sleep(1);
        if ((++sp & 255u) == 0u) { if (xb_ld(&bar[XB_TMO])) break; if (sp > XB_SPIN_CAP) { atomicAdd(&bar[XB_TMO], 1u); break; } }
    }
    nloc = mine > 0u ? mine : 1u; nx = cnt > 0u ? cnt : 1u;
}
__device__ __forceinline__ void xcd_barrier(const XcdBarrier& b) {
    asm volatile("s_waitcnt vmcnt(0)" ::: "memory");
    __syncthreads();
    int t0 = threadIdx.x; asm volatile("" : "+v"(t0));
    if (t0 == 0) {
        unsigned* bar = b.bar;
        __builtin_amdgcn_s_waitcnt(0);
        unsigned nloc = b.st[0], nx = b.st[1];
        if (nloc == 0u) { xcd_barrier_complete(bar, b.x, nloc, nx); b.st[0] = nloc; b.st[1] = nx; }
        const unsigned old = xb_add(&bar[XB_XSUB(b.x)], 1u);
        const unsigned gen = old / nloc;
        if (old + 1u == (gen + 1u) * nloc) {
            __builtin_amdgcn_fence(__ATOMIC_RELEASE, "agent");
            asm volatile("s_waitcnt vmcnt(0)" ::: "memory");
            const unsigned og = xb_add(&bar[XB_TOP], 1u);
            const unsigned tg = og / nx;
            if (og + 1u == (tg + 1u) * nx) xb_add(&bar[XB_TOPGEN], 1u);
            else XB_SPIN(xb_ld(&bar[XB_TOPGEN]) == tg, bar);
            __builtin_amdgcn_fence(__ATOMIC_ACQUIRE, "agent");
            xb_add(&bar[XB_XGEN(b.x)], 1u);
            asm volatile("s_waitcnt vmcnt(0)" ::: "memory");
        } else {
            XB_SPIN(xb_ld(&bar[XB_XGEN(b.x)]) == gen, bar);
            __builtin_amdgcn_fence(__ATOMIC_ACQUIRE, "agent");
            asm volatile("s_waitcnt vmcnt(0)" ::: "memory");
        }
    }
    __syncthreads();
}

__global__ void __launch_bounds__(NT, 2) mega_kernel(Params p, int mask) {
    __shared__ __attribute__((aligned(16))) char smem[SMEM_BYTES + 16];
    cg::grid_group grid = cg::this_grid();
    int tid = threadIdx.x;
    volatile XLAS unsigned* xst = (volatile XLAS unsigned*)(smem + SMEM_BYTES);
    if (tid < 4) xst[tid] = 0u;
    __syncthreads();
    const XcdBarrier xb = xcd_barrier_post(p.w.bar, xst);
    if (mask) grid.sync();
    phase0<0>(p, smem, tid, (int)blockIdx.x, (int)gridDim.x); xcd_barrier(xb);
    phase1(p, smem, tid);    xcd_barrier(xb);
    phase_sgu(p, smem, tid);
    phase2(p, smem, tid);    xcd_barrier(xb);
    phase3(p, smem, tid);
}

extern "C" void kernel_launch(void* const* d_in, const int* in_sizes, int n_in, void* d_out, int out_size, void* d_ws, size_t ws_size,
                              hipStream_t stream) {
    const float* x = (const float*)d_in[0];
    const float* norm_gain = (const float*)d_in[1];
    const float* w_in = (const float*)d_in[2];
    const float* sgu_ng = (const float*)d_in[3];
    const float* sgu_w = (const float*)d_in[4];
    const float* sgu_b = (const float*)d_in[5];
    const float* qg = (const float*)d_in[6];
    const float* kg = (const float*)d_in[7];
    const float* ikg = (const float*)d_in[8];
    const float* bng = (const float*)d_in[9];
    const float* w_out = (const float*)d_in[10];
    float* out = (float*)d_out;
    WS w = make_ws(d_ws);
    Params p{};
    p.x = x; p.norm_gain = norm_gain; p.w_in = w_in; p.sgu_ng = sgu_ng; p.sgu_w = sgu_w; p.sgu_b = sgu_b;
    p.qg = qg; p.kg = kg; p.ikg = ikg; p.bng = bng; p.w_out = w_out; p.out = out; p.w = w;
    static int grid_blocks = 0;
    if (!grid_blocks) {
        int dev = 0, cus = 0, per_cu = 0;
        (void)hipGetDevice(&dev);
        (void)hipDeviceGetAttribute(&cus, hipDeviceAttributeMultiprocessorCount, dev);
        (void)hipOccupancyMaxActiveBlocksPerMultiprocessor(&per_cu, mega_kernel, NT, 0);
        if (per_cu > 1) per_cu = 1;
        if (per_cu < 1) per_cu = 1;
        grid_blocks = cus * per_cu;
    }
    int mask1 = 0;
    (void)hipMemsetAsync(w.bar, 0, (size_t)4096 * 4, stream);
    {
        void* args[] = {&p, &mask1};
        hipError_t e = hipLaunchCooperativeKernel((void*)mega_kernel, dim3(grid_blocks), dim3(NT), args, 0, stream);
        if (e != hipSuccess) fprintf(stderr, "cooperative launch failed: %s (grid %d)\n", hipGetErrorString(e), grid_blocks);
    }
}
```

```cpp
#include <hip/hip_runtime.h>
#include <hip/hip_cooperative_groups.h>
#include <stdint.h>
#include <cstdio>
namespace cg = cooperative_groups;

typedef unsigned short bf16_t;
typedef short bf16x8 __attribute__((ext_vector_type(8)));
typedef float f32x4 __attribute__((ext_vector_type(4)));
typedef float f32x16 __attribute__((ext_vector_type(16)));
typedef unsigned u32x4 __attribute__((ext_vector_type(4)));
typedef unsigned u32x2 __attribute__((ext_vector_type(2)));

#define T_TOK 16384
#define SEQ 2048
#define NB 8
#define DM 1024
#define DIN 3272
#define EPS 1e-6f

__device__ __forceinline__ float bf2f(bf16_t v) { return __uint_as_float(((unsigned)v) << 16); }
__device__ __forceinline__ bf16_t f2bf(float f) {
    unsigned u = __float_as_uint(f);
    u += 0x7fffu + ((u >> 16) & 1u);
    return (bf16_t)(u >> 16);
}
__device__ __forceinline__ float gelu_tanh(float x) {
    const float t = x * x * 0.044715f + 1.0f;
    const float e = __builtin_amdgcn_exp2f(x * t * (-2.0f * 0.7978845608028654f * 1.4426950408889634f));
    return x * __builtin_amdgcn_rcpf(1.0f + e);
}
__device__ __forceinline__ float silu_f(float x) { return x * __builtin_amdgcn_rcpf(1.0f + __builtin_amdgcn_exp2f(x * -1.4426950408889634f)); }
__device__ __forceinline__ float wave_sum(float v) {
#pragma unroll
    for (int o = 32; o >= 1; o >>= 1) v += __shfl_xor(v, o);
    return v;
}
__device__ __forceinline__ int perm16(int k) { return k < 4 ? k : (k < 8 ? k + 4 : (k < 12 ? k - 4 : k)); }
__device__ __forceinline__ int vt_pos(int s) { return (s & ~15) | perm16(s & 15); }

struct WS {
    bf16_t* qn;
    bf16_t* qi;
    bf16_t* gz;
    bf16_t* mixed;
    bf16_t* kn;
    bf16_t* kin;
    bf16_t* vt;
    float* wi;
    float* rinv;
    bf16_t* xb;
    bf16_t* WinT;
    bf16_t* WoutT;
    bf16_t* Wm;
    bf16_t* gu;
    bf16_t* vn;
    bf16_t* gza;
    unsigned* bar;
};
static WS make_ws(void* d_ws) {
    char* p = (char*)d_ws; WS w;
    auto take = [&](size_t bytes) { char* r = p; p += (bytes + 255) & ~(size_t)255; return r; };
    w.qn = (bf16_t*)take((size_t)T_TOK * 512 * 2);
    w.qi = (bf16_t*)take((size_t)T_TOK * 512 * 2);
    w.gz = (bf16_t*)take((size_t)T_TOK * 512 * 2);
    w.mixed = (bf16_t*)take((size_t)T_TOK * 1024 * 2);
    w.kn = (bf16_t*)take((size_t)T_TOK * 64 * 2);
    w.kin = (bf16_t*)take((size_t)T_TOK * 64 * 2);
    w.vt = (bf16_t*)take((size_t)T_TOK * 64 * 2);
    w.wi = (float*)take((size_t)T_TOK * 8 * 4);
    w.rinv = (float*)take((size_t)T_TOK * 4);
    w.xb = (bf16_t*)take((size_t)T_TOK * 1024 * 2);
    w.WinT = (bf16_t*)take((size_t)3328 * 1024 * 2);
    w.WoutT = (bf16_t*)take((size_t)1024 * 1024 * 2);
    w.Wm = (bf16_t*)take((size_t)4 * 128 * 128 * 2);
    w.gu = (bf16_t*)take((size_t)T_TOK * 512 * 2);
    w.vn = (bf16_t*)take((size_t)T_TOK * 512 * 2);
    w.gza = (bf16_t*)take((size_t)T_TOK * 512 * 2);
    w.bar = (unsigned*)take((size_t)4096 * 4);
    return w;
}

#define LAS __attribute__((address_space(3)))
#define NT 512
#define LROW 72
#define RING_STAGE 49152
#define RING_BYTES (3 * RING_STAGE)
#define ST_OFF RING_BYTES
#define SMEM_BYTES (RING_BYTES + 4096)

struct Params {
    const float* x; const float* norm_gain; const float* w_in; const float* sgu_ng; const float* sgu_w; const float* sgu_b;
    const float* qg; const float* kg; const float* ikg; const float* bng; const float* w_out; float* out;
    WS w;
};

typedef float f32x2 __attribute__((ext_vector_type(2)));
typedef __bf16 hbf16x2 __attribute__((ext_vector_type(2)));
__device__ __forceinline__ unsigned pack_bf2(float lo, float hi) {
    const f32x2 v = {lo, hi};
    return __builtin_bit_cast(unsigned, __builtin_convertvector(v, hbf16x2));
}
__device__ __forceinline__ float bf_lo(unsigned u) { return __uint_as_float(u << 16); }
__device__ __forceinline__ float bf_hi(unsigned u) { return __uint_as_float(u & 0xffff0000u); }

__device__ __forceinline__ int opaque_grid() { int g = (int)gridDim.x; asm volatile("" : "+s"(g)); return g; }
#define GWAIT_V(n) asm volatile("s_waitcnt vmcnt(" #n ")" ::: "memory")
#define GBAR() do { __builtin_amdgcn_s_barrier(); asm volatile("" ::: "memory"); } while (0)
__device__ __forceinline__ void gemm_ring(const bf16_t* __restrict__ Wt, const bf16_t* __restrict__ Xt, char* smem, f32x4 (&acc)[4][4], int tid,
                                          int st0 = 0, int pre = 0, const bf16_t* __restrict__ nWt = nullptr, const bf16_t* __restrict__ nXt = nullptr) {
    const int wv = __builtin_amdgcn_readfirstlane(tid >> 6), lane = tid & 63, wm = wv >> 2, wn = wv & 3, fr = lane & 15, fq = lane >> 4;
    LAS char* lds = (LAS char*)smem;
    const int sc = (lane & 7) ^ ((((wv & 1) << 2) + (lane >> 4)) & 7);
    const bf16_t* gX = Xt + (size_t)(wv * 8 + (lane >> 3)) * DM + sc * 8;
    const bf16_t* gW = Wt + (size_t)(wv * 8 + (lane >> 3)) * DM + sc * 8;
    const bool has_next = nWt != nullptr;
    const bf16_t* gX2 = (has_next ? nXt : Xt) + (size_t)(wv * 8 + (lane >> 3)) * DM + sc * 8;
    const bf16_t* gW2 = (has_next ? nWt : Wt) + (size_t)(wv * 8 + (lane >> 3)) * DM + sc * 8;
#define GSTAGE_N(st, k0) do { LAS char* _b = lds + (st) * RING_STAGE + wv * 1024; \
        _Pragma("unroll") for (int _i = 0; _i < 4; ++_i) __builtin_amdgcn_global_load_lds((const unsigned*)(gX2 + (size_t)_i * 64 * DM + (k0)), (LAS unsigned*)(_b + _i * 8192), 16, 0, 0); \
        _Pragma("unroll") for (int _i = 0; _i < 2; ++_i) __builtin_amdgcn_global_load_lds((const unsigned*)(gW2 + (size_t)_i * 64 * DM + (k0)), (LAS unsigned*)(_b + 32768 + _i * 8192), 16, 0, 0); } while (0)
#define GSTAGE(st, k0) do { LAS char* _b = lds + (st) * RING_STAGE + wv * 1024; \
        _Pragma("unroll") for (int _i = 0; _i < 4; ++_i) __builtin_amdgcn_global_load_lds((const unsigned*)(gX + (size_t)_i * 64 * DM + (k0)), (LAS unsigned*)(_b + _i * 8192), 16, 0, 0); \
        _Pragma("unroll") for (int _i = 0; _i < 2; ++_i) __builtin_amdgcn_global_load_lds((const unsigned*)(gW + (size_t)_i * 64 * DM + (k0)), (LAS unsigned*)(_b + 32768 + _i * 8192), 16, 0, 0); } while (0)
    const int sl0 = ((fq) ^ (fr >> 1)) << 4, sl1 = ((4 + fq) ^ (fr >> 1)) << 4;
    const int offX = wn * 8192 + fr * 128, offW = 32768 + wm * 8192 + fr * 128;
#pragma unroll
    for (int mi = 0; mi < 4; ++mi)
#pragma unroll
        for (int ni = 0; ni < 4; ++ni) acc[mi][ni] = (f32x4){0.f, 0.f, 0.f, 0.f};
    const int s1 = (st0 == 2) ? 0 : st0 + 1, s2 = (s1 == 2) ? 0 : s1 + 1;
    GWAIT_V(0);
    GBAR();
    if (pre == 0) GSTAGE(st0, 0);
    if (pre != 1) GSTAGE(s1, 64);
    GSTAGE(s2, 128);
    bf16x8 A0[4], B0[4], A1[4], B1[4];
#define GLDFRAG(A_, B_, sb_, sl_) do { _Pragma("unroll") for (int _i = 0; _i < 4; ++_i) { \
        A_[_i] = *(const LAS bf16x8*)((sb_) + offW + _i * 2048 + (sl_)); B_[_i] = *(const LAS bf16x8*)((sb_) + offX + _i * 2048 + (sl_)); } } while (0)
#define GMMA(A_, B_) do { _Pragma("unroll") for (int _m = 0; _m < 4; ++_m) _Pragma("unroll") for (int _n = 0; _n < 4; ++_n) \
        acc[_m][_n] = __builtin_amdgcn_mfma_f32_16x16x32_bf16(A_[_m], B_[_n], acc[_m][_n], 0, 0, 0); } while (0)
#define GMMA_ROW(A_, B_, m_) do { __builtin_amdgcn_s_setprio(1); _Pragma("unroll") for (int _n = 0; _n < 4; ++_n) \
        acc[m_][_n] = __builtin_amdgcn_mfma_f32_16x16x32_bf16(A_[m_], B_[_n], acc[m_][_n], 0, 0, 0); __builtin_amdgcn_s_setprio(0); } while (0)
    if (pre == 0) { GWAIT_V(12); GBAR(); }
    GLDFRAG(A0, B0, lds + st0 * RING_STAGE, sl0);
    int st = st0;
    for (int kt = 0; kt < 16; ++kt) {
        const LAS char* sb = lds + st * RING_STAGE;
        const int sn = (st == 2) ? 0 : st + 1;
        GMMA_ROW(A0, B0, 0);
        __builtin_amdgcn_sched_barrier(0);
        GLDFRAG(A1, B1, sb, sl1);
        __builtin_amdgcn_sched_barrier(0);
        GMMA_ROW(A0, B0, 1); GMMA_ROW(A0, B0, 2); GMMA_ROW(A0, B0, 3);
        __builtin_amdgcn_sched_barrier(0);
        if (kt < 15) {
            if (kt < 14 || has_next) GWAIT_V(6); else GWAIT_V(0);
            asm volatile("s_waitcnt lgkmcnt(0)" ::: "memory");
            GBAR();
            if (wv < 4) {
                if (kt + 3 < 16) GSTAGE(st, (kt + 3) * 64);
                else if (has_next) GSTAGE_N(st, (kt - 13) * 64);
            }
        }
        GMMA_ROW(A1, B1, 0);
        __builtin_amdgcn_sched_barrier(0);
        if (kt < 15) GLDFRAG(A0, B0, lds + sn * RING_STAGE, sl0);
        __builtin_amdgcn_sched_barrier(0);
        GMMA_ROW(A1, B1, 1); GMMA_ROW(A1, B1, 2); GMMA_ROW(A1, B1, 3);
        __builtin_amdgcn_sched_barrier(0);
        if (wv >= 4 && kt < 15) {
            if (kt + 3 < 16) GSTAGE(st, (kt + 3) * 64);
            else if (has_next) GSTAGE_N(st, (kt - 13) * 64);
        }
        __builtin_amdgcn_sched_barrier(0);
        st = sn;
    }
#undef GMMA_ROW
#undef GLDFRAG
#undef GMMA
#undef GSTAGE
#undef GSTAGE_N
}

#define R2_STAGE 65536
__device__ __forceinline__ void gemm_ring256(const bf16_t* __restrict__ Wt, const bf16_t* __restrict__ Xt, char* smem, f32x4 (&acc)[8][4], int tid, bool pre = false) {
    const int wv = __builtin_amdgcn_readfirstlane(tid >> 6), lane = tid & 63, wm = wv >> 2, wn = wv & 3, fr = lane & 15, fq = lane >> 4;
    LAS char* lds = (LAS char*)smem;
    const int sc = (lane & 7) ^ ((((wv & 1) << 2) + (lane >> 4)) & 7);
    const bf16_t* gX = Xt + (size_t)(wv * 8 + (lane >> 3)) * DM + sc * 8;
    const bf16_t* gW = Wt + (size_t)(wv * 8 + (lane >> 3)) * DM + sc * 8;
#define G2STAGE(st, k0) do { LAS char* _b = lds + (st) * R2_STAGE + wv * 1024; \
        _Pragma("unroll") for (int _i = 0; _i < 4; ++_i) __builtin_amdgcn_global_load_lds((const unsigned*)(gX + (size_t)_i * 64 * DM + (k0)), (LAS unsigned*)(_b + _i * 8192), 16, 0, 0); \
        _Pragma("unroll") for (int _i = 0; _i < 4; ++_i) __builtin_amdgcn_global_load_lds((const unsigned*)(gW + (size_t)_i * 64 * DM + (k0)), (LAS unsigned*)(_b + 32768 + _i * 8192), 16, 0, 0); } while (0)
    const int sl0 = ((fq) ^ (fr >> 1)) << 4, sl1 = ((4 + fq) ^ (fr >> 1)) << 4;
    const int offX = wn * 8192 + fr * 128, offW = 32768 + wm * 16384 + fr * 128;
#pragma unroll
    for (int mi = 0; mi < 8; ++mi)
#pragma unroll
        for (int ni = 0; ni < 4; ++ni) acc[mi][ni] = (f32x4){0.f, 0.f, 0.f, 0.f};
    GWAIT_V(0);
    GBAR();
    if (!pre) G2STAGE(0, 0);
    G2STAGE(1, 64);
    bf16x8 A0[8], B0[4], A1[8], B1[4];
#define G2LDFRAG(A_, B_, sb_, sl_) do { _Pragma("unroll") for (int _i = 0; _i < 8; ++_i) A_[_i] = *(const LAS bf16x8*)((sb_) + offW + _i * 2048 + (sl_)); \
        _Pragma("unroll") for (int _i = 0; _i < 4; ++_i) B_[_i] = *(const LAS bf16x8*)((sb_) + offX + _i * 2048 + (sl_)); } while (0)
#define G2MMA_ROW(A_, B_, m_) do { __builtin_amdgcn_s_setprio(1); _Pragma("unroll") for (int _n = 0; _n < 4; ++_n) \
        acc[m_][_n] = __builtin_amdgcn_mfma_f32_16x16x32_bf16(A_[m_], B_[_n], acc[m_][_n], 0, 0, 0); __builtin_amdgcn_s_setprio(0); } while (0)
    if (!pre) { GWAIT_V(8); GBAR(); }
    G2LDFRAG(A0, B0, lds, sl0);
    for (int kt = 0; kt < 16; ++kt) {
        const int s = kt & 1;
        const LAS char* sb = lds + s * R2_STAGE;
        G2MMA_ROW(A0, B0, 0);
        __builtin_amdgcn_sched_barrier(0);
        G2LDFRAG(A1, B1, sb, sl1);
        __builtin_amdgcn_sched_barrier(0);
        G2MMA_ROW(A0, B0, 1); G2MMA_ROW(A0, B0, 2); G2MMA_ROW(A0, B0, 3); G2MMA_ROW(A0, B0, 4); G2MMA_ROW(A0, B0, 5); G2MMA_ROW(A0, B0, 6); G2MMA_ROW(A0, B0, 7);
        __builtin_amdgcn_sched_barrier(0);
        if (kt < 15) {
            GWAIT_V(0);
            asm volatile("s_waitcnt lgkmcnt(0)" ::: "memory");
            GBAR();
            if (kt + 2 < 16 && wv < 4) G2STAGE(s, (kt + 2) * 64);
        }
        G2MMA_ROW(A1, B1, 0);
        __builtin_amdgcn_sched_barrier(0);
        if (kt < 15) G2LDFRAG(A0, B0, lds + (s ^ 1) * R2_STAGE, sl0);
        __builtin_amdgcn_sched_barrier(0);
        G2MMA_ROW(A1, B1, 1); G2MMA_ROW(A1, B1, 2); G2MMA_ROW(A1, B1, 3); G2MMA_ROW(A1, B1, 4); G2MMA_ROW(A1, B1, 5); G2MMA_ROW(A1, B1, 6); G2MMA_ROW(A1, B1, 7);
        __builtin_amdgcn_sched_barrier(0);
        if (kt + 2 < 16 && wv >= 4) G2STAGE(s, (kt + 2) * 64);
        __builtin_amdgcn_sched_barrier(0);
    }
#undef G2MMA_ROW
#undef G2LDFRAG
#undef G2STAGE
}

__device__ __forceinline__ void g2_prefetch0(const bf16_t* __restrict__ Wt, const bf16_t* __restrict__ Xt, char* smem, int tid) {
    const int wv = __builtin_amdgcn_readfirstlane(tid >> 6), lane = tid & 63;
    LAS char* lds = (LAS char*)smem;
    const int sc = (lane & 7) ^ ((((wv & 1) << 2) + (lane >> 4)) & 7);
    const bf16_t* gX = Xt + (size_t)(wv * 8 + (lane >> 3)) * DM + sc * 8;
    const bf16_t* gW = Wt + (size_t)(wv * 8 + (lane >> 3)) * DM + sc * 8;
    LAS char* b = lds + wv * 1024;
#pragma unroll
    for (int i = 0; i < 4; ++i) __builtin_amdgcn_global_load_lds((const unsigned*)(gX + (size_t)i * 64 * DM), (LAS unsigned*)(b + i * 8192), 16, 0, 0);
#pragma unroll
    for (int i = 0; i < 4; ++i) __builtin_amdgcn_global_load_lds((const unsigned*)(gW + (size_t)i * 64 * DM), (LAS unsigned*)(b + 32768 + i * 8192), 16, 0, 0);
}

__device__ __forceinline__ void g1_prefetch0(const bf16_t* __restrict__ Wt, const bf16_t* __restrict__ Xt, char* smem, int tid) {
    const int wv = __builtin_amdgcn_readfirstlane(tid >> 6), lane = tid & 63;
    LAS char* lds = (LAS char*)smem;
    const int sc = (lane & 7) ^ ((((wv & 1) << 2) + (lane >> 4)) & 7);
    const bf16_t* gX = Xt + (size_t)(wv * 8 + (lane >> 3)) * DM + sc * 8;
    const bf16_t* gW = Wt + (size_t)(wv * 8 + (lane >> 3)) * DM + sc * 8;
    LAS char* b = lds + wv * 1024;
#pragma unroll
    for (int i = 0; i < 4; ++i) __builtin_amdgcn_global_load_lds((const unsigned*)(gX + (size_t)i * 64 * DM), (LAS unsigned*)(b + i * 8192), 16, 0, 0);
#pragma unroll
    for (int i = 0; i < 2; ++i) __builtin_amdgcn_global_load_lds((const unsigned*)(gW + (size_t)i * 64 * DM), (LAS unsigned*)(b + 32768 + i * 8192), 16, 0, 0);
}

__device__ __forceinline__ void transpose_tile(const float* __restrict__ src, int ld_src, int ncols_valid, const float* __restrict__ gain, bf16_t* __restrict__ dst,
                               int k0, int e0, float* tile  , int tid) {
    __syncthreads();
    f32x4 v[4];
#pragma unroll
    for (int p = 0; p < 4; ++p) {
        const int k = p * 16 + (tid >> 5), e = (tid & 31) * 4;
        const float* s = src + (size_t)(k0 + k) * ld_src + e0 + e;
        if (e0 + e + 3 < ncols_valid) v[p] = __builtin_nontemporal_load((const f32x4*)s);
        else { v[p] = (f32x4){0.f, 0.f, 0.f, 0.f};
#pragma unroll
            for (int i = 0; i < 4; ++i) if (e0 + e + i < ncols_valid) v[p][i] = s[i]; }
    }
#pragma unroll
    for (int p = 0; p < 4; ++p) {
        const int k = p * 16 + (tid >> 5), e = (tid & 31) * 4;
        const float g = gain ? gain[k0 + k] : 1.0f;
        *(f32x4*)(tile + k * 132 + e) = v[p] * g;
    }
    __syncthreads();
#pragma unroll
    for (int p = 0; p < 2; ++p) {
        const int e = (tid >> 3) + 64 * p, c = (tid & 7) * 8;
        u32x4 o;
        o.x = pack_bf2(tile[(c + 0) * 132 + e], tile[(c + 1) * 132 + e]);
        o.y = pack_bf2(tile[(c + 2) * 132 + e], tile[(c + 3) * 132 + e]);
        o.z = pack_bf2(tile[(c + 4) * 132 + e], tile[(c + 5) * 132 + e]);
        o.w = pack_bf2(tile[(c + 6) * 132 + e], tile[(c + 7) * 132 + e]);
        *(u32x4*)(dst + (size_t)(e0 + e) * 1024 + k0 + c) = o;
    }
}
template <int MODE>
__device__ __forceinline__ void phase0(const Params& p, char* smem, int tid, int i0, int di) {
    asm volatile("" : "+v"(tid));
    const int wv = tid >> 6, lane = tid & 63;
    const int N_TIN = 16 * 26, N_TOUT = 16 * 8, N_WM = 32, N_ROWS = T_TOK / 32;
    const int total = MODE == 0 ? N_TIN + N_ROWS : N_TOUT + N_WM;
    for (int it0 = i0; it0 < total; it0 += di) {
        const int it = MODE == 0 ? (it0 < N_TIN ? it0 : it0 + N_TOUT + N_WM) : it0 + N_TIN;
        if (it < N_TIN) {
            const int kt = it & 15, et = it >> 4;
            transpose_tile(p.w_in, DIN, DIN, p.norm_gain, p.w.WinT, kt * 64, et * 128, (float*)smem, tid);
        } else if (it < N_TIN + N_TOUT) {
            const int t = it - N_TIN, kt = t & 15, et = t >> 4;
            transpose_tile(p.w_out, DM, DM, nullptr, p.w.WoutT, kt * 64, et * 128, (float*)smem, tid);
        } else if (it < N_TIN + N_TOUT + N_WM) {
            const int t = it - N_TIN - N_TOUT;
#pragma unroll
            for (int q = 0; q < 4; ++q) {
                const int e = t * 2048 + q * 512 + tid, i = (e >> 7) & 127, j = e & 127;
                const float v = ((j >> 6) <= (i >> 6)) ? p.sgu_w[e] : 0.f;
                p.w.Wm[e] = f2bf(v);
            }
        } else {
            const int row0 = (it - N_TIN - N_TOUT - N_WM) * 32 + wv * 4;
            f32x4 v[4][4];
#pragma unroll
            for (int r = 0; r < 4; ++r)
#pragma unroll
                for (int i = 0; i < 4; ++i) v[r][i] = __builtin_nontemporal_load((const f32x4*)(p.x + (size_t)(row0 + r) * DM + i * 256 + lane * 4));
#pragma unroll
            for (int r = 0; r < 4; ++r) {
                float s = 0.f;
#pragma unroll
                for (int i = 0; i < 4; ++i) s += v[r][i][0] * v[r][i][0] + v[r][i][1] * v[r][i][1] + v[r][i][2] * v[r][i][2] + v[r][i][3] * v[r][i][3];
                s = wave_sum(s);
                if (lane == 0) p.w.rinv[row0 + r] = rsqrtf(s * (1.0f / DM) + EPS);
#pragma unroll
                for (int i = 0; i < 4; ++i) {
                    u32x2 o; o.x = pack_bf2(v[r][i][0], v[r][i][1]); o.y = pack_bf2(v[r][i][2], v[r][i][3]);
                    *(u32x2*)(p.w.xb + (size_t)(row0 + r) * DM + i * 256 + lane * 4) = o;
                }
            }
        }
    }
}

__device__ __forceinline__ float quad_sum(float v) { v += __shfl_xor(v, 16); v += __shfl_xor(v, 32); return v; }

__device__ __forceinline__ void p1_unit(const Params& p, int tb, int ct, char* smem, int tid, int st0 = 0, int pre = 0, int ntb = -1, int nct = 0) {
    asm volatile("" : "+v"(tid));
    const int wv = tid >> 6, lane = tid & 63, wm = wv >> 2, wn = wv & 3, fr = lane & 15, fq = lane >> 4;
    float* st = (float*)(smem + ST_OFF);
    float rr[4];
#pragma unroll
    for (int ni = 0; ni < 4; ++ni) rr[ni] = p.w.rinv[tb * 256 + wn * 64 + ni * 16 + fr];
    f32x4 acc[4][4];
    gemm_ring(p.w.WinT + (size_t)ct * 128 * DM, p.w.xb + (size_t)tb * 256 * DM, smem, acc, tid, st0, pre,
              ntb >= 0 ? p.w.WinT + (size_t)nct * 128 * DM : nullptr, ntb >= 0 ? p.w.xb + (size_t)ntb * 256 * DM : nullptr);
    u32x2 ov[4][4];
    bf16_t* dtile = nullptr;
    if (ct >= 4 && ct < 8) {
#pragma unroll
        for (int ni = 0; ni < 4; ++ni) {
            float s1 = 0.f, s2 = 0.f;
#pragma unroll
            for (int mi = 0; mi < 4; ++mi)
#pragma unroll
                for (int i = 0; i < 4; ++i) { const float gvv = gelu_tanh(acc[mi][ni][i] * rr[ni]); acc[mi][ni][i] = gvv; s1 += gvv; s2 += gvv * gvv; }
            s1 = quad_sum(s1); s2 = quad_sum(s2);
            if (fq == 0) { const int tl = wn * 64 + ni * 16 + fr; st[(tl * 2 + wm) * 2 + 0] = s1; st[(tl * 2 + wm) * 2 + 1] = s2; }
            __builtin_amdgcn_sched_barrier(0);
        }
        __syncthreads();
#pragma unroll
        for (int ni = 0; ni < 4; ++ni) {
            const int tl = wn * 64 + ni * 16 + fr;
            const f32x4 sv = *(const f32x4*)(st + tl * 4);
            const float mu = (sv[0] + sv[2]) * (1.0f / 128.0f);
            const float var = (sv[1] + sv[3]) * (1.0f / 128.0f) - mu * mu;
            const float rs = rsqrtf(fmaxf(var, 0.f) + EPS);
#pragma unroll
            for (int mi = 0; mi < 4; ++mi) {
                const f32x4 gn = *(const f32x4*)(p.sgu_ng + (ct - 4) * 128 + wm * 64 + mi * 16 + fq * 4);
                ov[mi][ni].x = pack_bf2((acc[mi][ni][0] - mu) * rs * gn[0], (acc[mi][ni][1] - mu) * rs * gn[1]);
                ov[mi][ni].y = pack_bf2((acc[mi][ni][2] - mu) * rs * gn[2], (acc[mi][ni][3] - mu) * rs * gn[3]);
            }
            __builtin_amdgcn_sched_barrier(0);
        }
        dtile = p.w.vn + (size_t)tb * 256 * 512 + (ct - 4) * 128;
    } else {
#pragma unroll
        for (int ni = 0; ni < 4; ++ni) {
            const int tok = tb * 256 + wn * 64 + ni * 16 + fr;
            const float r = rr[ni];
            f32x4 v[4];
#pragma unroll
            for (int mi = 0; mi < 4; ++mi) v[mi] = acc[mi][ni] * r;
            if (ct < 4) {
#pragma unroll
                for (int mi = 0; mi < 4; ++mi) { ov[mi][ni].x = pack_bf2(gelu_tanh(v[mi][0]), gelu_tanh(v[mi][1])); ov[mi][ni].y = pack_bf2(gelu_tanh(v[mi][2]), gelu_tanh(v[mi][3])); }
            } else if (ct < 12 || (ct >= 17 && ct < 21)) {
#pragma unroll
                for (int mi = 0; mi < 4; ++mi) { ov[mi][ni].x = pack_bf2(silu_f(v[mi][0]), silu_f(v[mi][1])); ov[mi][ni].y = pack_bf2(silu_f(v[mi][2]), silu_f(v[mi][3])); }
            } else if (ct < 16 || (ct == 16 && wm == 0)) {
                float ss = 0.f;
#pragma unroll
                for (int mi = 0; mi < 4; ++mi) ss += v[mi][0] * v[mi][0] + v[mi][1] * v[mi][1] + v[mi][2] * v[mi][2] + v[mi][3] * v[mi][3];
                ss = quad_sum(ss);
                const bool isq = ct < 16;
                const float sc = rsqrtf(ss * (1.0f / 64.0f) + EPS) * (isq ? (0.125f * 1.4426950408889634f) : 1.0f);
                const float* gain = isq ? p.qg : p.kg;
#pragma unroll
                for (int mi = 0; mi < 4; ++mi) {
                    const int d = mi * 16 + fq * 4;
                    const f32x4 gv = *(const f32x4*)(gain + d);
                    u32x2 o; o.x = pack_bf2(v[mi][0] * sc * gv[0], v[mi][1] * sc * gv[1]); o.y = pack_bf2(v[mi][2] * sc * gv[2], v[mi][3] * sc * gv[3]);
                    if (isq) ov[mi][ni] = o; else *(u32x2*)(p.w.kn + (size_t)tok * 64 + d) = o;
                }
            } else if (ct == 16) {
                const int b = tok >> 11, pos = tok & 2047;
#pragma unroll
                for (int mi = 0; mi < 4; ++mi)
#pragma unroll
                    for (int i = 0; i < 4; ++i) p.w.vt[((size_t)b * 64 + mi * 16 + fq * 4 + i) * SEQ + vt_pos(pos)] = f2bf(v[mi][i]);
            } else if (ct < 25) {
#pragma unroll
                for (int mi = 0; mi < 4; ++mi) { ov[mi][ni].x = pack_bf2(v[mi][0], v[mi][1]); ov[mi][ni].y = pack_bf2(v[mi][2], v[mi][3]); }
            } else if (wm == 0) {
                float s1 = 0.f;
#pragma unroll
                for (int mi = 0; mi < 4; ++mi) s1 += v[mi][0] + v[mi][1] + v[mi][2] + v[mi][3];
                s1 = quad_sum(s1);
                const float mu = s1 * (1.0f / 64.0f);
                float s2 = 0.f;
#pragma unroll
                for (int mi = 0; mi < 4; ++mi) { v[mi] = v[mi] - mu; s2 += v[mi][0] * v[mi][0] + v[mi][1] * v[mi][1] + v[mi][2] * v[mi][2] + v[mi][3] * v[mi][3]; }
                s2 = quad_sum(s2);
                const float rs = rsqrtf(s2 * (1.0f / 64.0f) + EPS);
#pragma unroll
                for (int mi = 0; mi < 4; ++mi) {
                    const int d = mi * 16 + fq * 4;
                    const f32x4 gv = *(const f32x4*)(p.ikg + d);
                    u32x2 o; o.x = pack_bf2(v[mi][0] * rs * gv[0], v[mi][1] * rs * gv[1]); o.y = pack_bf2(v[mi][2] * rs * gv[2], v[mi][3] * rs * gv[3]);
                    *(u32x2*)(p.w.kin + (size_t)tok * 64 + d) = o;
                }
            } else {
                if (fq < 2) *(f32x4*)(p.w.wi + (size_t)tok * 8 + fq * 4) = v[0] * 0.04419417382415922f;
            }
            __builtin_amdgcn_sched_barrier(0);
        }
        if (ct < 4) dtile = p.w.gu + (size_t)tb * 256 * 512 + ct * 128;
        else if (ct < 12) dtile = p.w.gza + (size_t)tb * 256 * 512 + (ct - 8) * 128;
        else if (ct < 16) dtile = p.w.qn + (size_t)tb * 256 * 512 + (ct - 12) * 128;
        else if (ct >= 17 && ct < 21) dtile = p.w.gz + (size_t)tb * 256 * 512 + (ct - 17) * 128;
        else if (ct >= 21 && ct < 25) dtile = p.w.qi + (size_t)tb * 256 * 512 + (ct - 21) * 128;
    }
    if (dtile) {
        bf16_t* img = (bf16_t*)(smem + st0 * RING_STAGE);
        __syncthreads();
#pragma unroll
        for (int hf = 0; hf < 2; ++hf) {
            if ((wn >> 1) == hf) {
#pragma unroll
                for (int ni = 0; ni < 4; ++ni)
#pragma unroll
                    for (int mi = 0; mi < 4; ++mi) *(u32x2*)(img + ((wn & 1) * 64 + ni * 16 + fr) * 136 + wm * 64 + mi * 16 + fq * 4) = ov[mi][ni];
            }
            __syncthreads();
#pragma unroll
            for (int ps = 0; ps < 4; ++ps) {
                const int row = ps * 32 + (tid >> 4), ck = (tid & 15) * 8;
                const u32x4 t = *(const u32x4*)(img + row * 136 + ck);
                *(u32x4*)(dtile + (size_t)(hf * 128 + row) * 512 + ck) = t;
            }
            if (hf == 0) __syncthreads();
        }
    }
}

__device__ __forceinline__ void p1_unit256(const Params& p, int tb, int d, char* smem, int tid, bool pre, int ntb, int nd, int nstb, int nsct) {
    f32x4 acc[8][4];
    gemm_ring256(p.w.WinT + (size_t)d * 256 * DM, p.w.xb + (size_t)tb * 256 * DM, smem, acc, tid, pre);
    asm volatile("" : "+v"(tid));
    const int wv = tid >> 6, lane = tid & 63, wm = wv >> 2, wn = wv & 3, fr = lane & 15, fq = lane >> 4;
    const int ct = 2 * d + wm;
    float rr[4];
#pragma unroll
    for (int ni = 0; ni < 4; ++ni) rr[ni] = p.w.rinv[tb * 256 + wn * 64 + ni * 16 + fr];
    __syncthreads();
    if (ntb >= 0) g2_prefetch0(p.w.WinT + (size_t)nd * 256 * DM, p.w.xb + (size_t)ntb * 256 * DM, smem, tid);
    else if (nstb >= 0) g1_prefetch0(p.w.WinT + (size_t)nsct * 128 * DM, p.w.xb + (size_t)nstb * 256 * DM, smem, tid);
    bf16_t* dbase = ct < 4 ? p.w.gu + ct * 128 : ct < 8 ? p.w.vn + (ct - 4) * 128 : ct < 12 ? p.w.gza + (ct - 8) * 128 : ct < 16 ? p.w.qn + (ct - 12) * 128
                  : ct < 21 ? p.w.gz + (ct - 17) * 128 : p.w.qi + (ct - 21) * 128;
    bf16_t* img = (bf16_t*)(smem + 65536 + wv * 8704);
#pragma unroll
    for (int hf = 0; hf < 2; ++hf) {
#pragma unroll
    for (int n2 = 0; n2 < 2; ++n2) {
        const int ni = hf * 2 + n2;
        const int tok = tb * 256 + wn * 64 + ni * 16 + fr;
        const float r = rr[ni];
        bf16_t* dst = img + (n2 * 16 + fr) * 136 + fq * 4;
        f32x4 v[8];
#pragma unroll
        for (int mi = 0; mi < 8; ++mi) v[mi] = acc[mi][ni] * r;
        if (ct < 4) {
#pragma unroll
            for (int mi = 0; mi < 8; ++mi) { u32x2 o; o.x = pack_bf2(gelu_tanh(v[mi][0]), gelu_tanh(v[mi][1])); o.y = pack_bf2(gelu_tanh(v[mi][2]), gelu_tanh(v[mi][3])); *(u32x2*)(dst + mi * 16) = o; }
        } else if (ct < 8) {
            float s1 = 0.f, s2 = 0.f;
#pragma unroll
            for (int mi = 0; mi < 8; ++mi)
#pragma unroll
                for (int i = 0; i < 4; ++i) { const float gvv = gelu_tanh(v[mi][i]); v[mi][i] = gvv; s1 += gvv; s2 += gvv * gvv; }
            s1 = quad_sum(s1); s2 = quad_sum(s2);
            const float mu = s1 * (1.0f / 128.0f);
            const float rs = rsqrtf(fmaxf(s2 * (1.0f / 128.0f) - mu * mu, 0.f) + EPS);
#pragma unroll
            for (int mi = 0; mi < 8; ++mi) {
                const f32x4 gn = *(const f32x4*)(p.sgu_ng + (ct - 4) * 128 + mi * 16 + fq * 4);
                u32x2 o; o.x = pack_bf2((v[mi][0] - mu) * rs * gn[0], (v[mi][1] - mu) * rs * gn[1]); o.y = pack_bf2((v[mi][2] - mu) * rs * gn[2], (v[mi][3] - mu) * rs * gn[3]);
                *(u32x2*)(dst + mi * 16) = o;
            }
        } else if (ct < 12 || (ct >= 17 && ct < 21)) {
#pragma unroll
            for (int mi = 0; mi < 8; ++mi) { u32x2 o; o.x = pack_bf2(silu_f(v[mi][0]), silu_f(v[mi][1])); o.y = pack_bf2(silu_f(v[mi][2]), silu_f(v[mi][3])); *(u32x2*)(dst + mi * 16) = o; }
        } else if (ct < 16) {
#pragma unroll
            for (int hh = 0; hh < 2; ++hh) {
                float ss = 0.f;
#pragma unroll
                for (int m4 = 0; m4 < 4; ++m4) { const f32x4 t = v[hh * 4 + m4]; ss += t[0] * t[0] + t[1] * t[1] + t[2] * t[2] + t[3] * t[3]; }
                ss = quad_sum(ss);
                const float sc = rsqrtf(ss * (1.0f / 64.0f) + EPS) * (0.125f * 1.4426950408889634f);
#pragma unroll
                for (int m4 = 0; m4 < 4; ++m4) {
                    const f32x4 gv = *(const f32x4*)(p.qg + m4 * 16 + fq * 4); const f32x4 t = v[hh * 4 + m4];
                    u32x2 o; o.x = pack_bf2(t[0] * sc * gv[0], t[1] * sc * gv[1]); o.y = pack_bf2(t[2] * sc * gv[2], t[3] * sc * gv[3]);
                    *(u32x2*)(dst + (hh * 4 + m4) * 16) = o;
                }
            }
        } else if (ct == 16) {
            float ss = 0.f;
#pragma unroll
            for (int m4 = 0; m4 < 4; ++m4) { const f32x4 t = v[m4]; ss += t[0] * t[0] + t[1] * t[1] + t[2] * t[2] + t[3] * t[3]; }
            ss = quad_sum(ss);
            const float sc = rsqrtf(ss * (1.0f / 64.0f) + EPS);
#pragma unroll
            for (int m4 = 0; m4 < 4; ++m4) {
                const f32x4 gv = *(const f32x4*)(p.kg + m4 * 16 + fq * 4); const f32x4 t = v[m4];
                u32x2 o; o.x = pack_bf2(t[0] * sc * gv[0], t[1] * sc * gv[1]); o.y = pack_bf2(t[2] * sc * gv[2], t[3] * sc * gv[3]);
                *(u32x2*)(p.w.kn + (size_t)tok * 64 + m4 * 16 + fq * 4) = o;
            }
            const int b = tok >> 11, pos = tok & 2047;
#pragma unroll
            for (int m4 = 0; m4 < 4; ++m4)
#pragma unroll
                for (int i = 0; i < 4; ++i) p.w.vt[((size_t)b * 64 + m4 * 16 + fq * 4 + i) * SEQ + vt_pos(pos)] = f2bf(v[4 + m4][i]);
        } else {
#pragma unroll
            for (int mi = 0; mi < 8; ++mi) { u32x2 o; o.x = pack_bf2(v[mi][0], v[mi][1]); o.y = pack_bf2(v[mi][2], v[mi][3]); *(u32x2*)(dst + mi * 16) = o; }
        }
        __builtin_amdgcn_sched_barrier(0);
    }
    if (ct != 16) {
        bf16_t* grow = dbase + (size_t)(tb * 256 + wn * 64 + hf * 32) * 512;
#pragma unroll
        for (int ps = 0; ps < 8; ++ps) {
            const int row = ps * 4 + (lane >> 4), ck = (lane & 15) * 8;
            const u32x4 t = *(const u32x4*)(img + row * 136 + ck);
            *(u32x4*)(grow + (size_t)row * 512 + ck) = t;
        }
    }
    }
}

__device__ __forceinline__ void phase1(const Params& p, char* smem, int tid) {
    const int x = blockIdx.x & 7, li = blockIdx.x >> 3;
    const bool xaw = (opaque_grid() == 256);
    const int jlim = xaw ? 96 : 768, jst = xaw ? 32 : (int)gridDim.x;
    bool pre = false;
    for (int j = xaw ? li : (int)blockIdx.x; j < jlim; j += jst) {
        const int tb = xaw ? x + 8 * (4 * (j / 48) + (j & 3)) : j / 12, d = xaw ? (j % 48) / 4 : j % 12;
        const int jn = j + jst;
        const int ntb = jn < jlim ? (xaw ? x + 8 * (4 * (jn / 48) + (jn & 3)) : jn / 12) : -1, nd = xaw ? (jn % 48) / 4 : jn % 12;
        const int nstb = (xaw && ntb < 0 && li < 16) ? x + 8 * (li >> 1) : -1;
        p1_unit256(p, tb, d, smem, tid, pre, ntb, nd, nstb, 24 + (li & 1));
        pre = true;
    }
    for (int u = xaw ? (li < 16 ? li : 128) : (int)blockIdx.x; u < (xaw ? 16 : 128); u += xaw ? 128 : (int)gridDim.x)
        p1_unit(p, xaw ? x + 8 * (u >> 1) : u >> 1, 24 + (u & 1), smem, tid, 0, xaw ? 2 : 0);
    if (xaw) { if (li >= 16) phase0<1>(p, smem, tid, x * 16 + (li - 16), 128); }
    else phase0<1>(p, smem, tid, (int)blockIdx.x, (int)gridDim.x);
}

#define VNT_ROW 136
struct SguOps { u32x4 r[4]; bf16x8 bw[4][2]; u32x2 guv[2][4], zv[2][4]; float bi[2]; };
__device__ __forceinline__ void sgu_load(const Params& p, int nb, int g, int tid, SguOps& o) {
    const int wv = tid >> 6, lane = tid & 63, wm = wv >> 2, wn = wv & 3, fr = lane & 15, fq = lane >> 4;
    const int j = tid >> 2, c0 = (tid & 3) * 32;
    {
        const bf16_t* src = p.w.vn + (size_t)(nb * 128 + j) * 512 + g * 128 + c0;
#pragma unroll
        for (int q = 0; q < 4; ++q) o.r[q] = *(const u32x4*)(src + q * 8);
    }
    const bf16_t* Wg = p.w.Wm + (size_t)g * 128 * 128;
#pragma unroll
    for (int ks = 0; ks < 4; ++ks)
#pragma unroll
        for (int i = 0; i < 2; ++i) o.bw[ks][i] = *(const bf16x8*)(Wg + (size_t)(wn * 32 + i * 16 + fr) * 128 + ks * 32 + fq * 8);
#pragma unroll
    for (int ni = 0; ni < 2; ++ni) {
        const int tl = wn * 32 + ni * 16 + fr;
        o.bi[ni] = p.sgu_b[g * 128 + tl];
#pragma unroll
        for (int mi = 0; mi < 4; ++mi) {
            const size_t off = (size_t)(nb * 128 + tl) * 512 + g * 128 + wm * 64 + mi * 16 + fq * 4;
            o.guv[ni][mi] = *(const u32x2*)(p.w.gu + off);
            o.zv[ni][mi] = *(const u32x2*)(p.w.gza + off);
        }
    }
}
template <bool NEXT>
__device__ __forceinline__ void sgu_compute(const Params& p, int nb, int g, char* smem, int tid, SguOps& o, int nnb, int ng, SguOps& nx) {
    const int wv = tid >> 6, lane = tid & 63, wm = wv >> 2, wn = wv & 3, fr = lane & 15, fq = lane >> 4;
    bf16_t* vnT = (bf16_t*)smem;
    float* st = (float*)(smem + 36864);
    const int j = tid >> 2, c0 = (tid & 3) * 32;
    __syncthreads();
#pragma unroll
    for (int q = 0; q < 4; ++q) {
        const unsigned wds[4] = {o.r[q].x, o.r[q].y, o.r[q].z, o.r[q].w};
#pragma unroll
        for (int e = 0; e < 4; ++e) {
            vnT[(c0 + q * 8 + 2 * e) * VNT_ROW + j] = (bf16_t)(wds[e] & 0xffffu);
            vnT[(c0 + q * 8 + 2 * e + 1) * VNT_ROW + j] = (bf16_t)(wds[e] >> 16);
        }
    }
    __syncthreads();
    if (NEXT) sgu_load(p, nnb, ng, tid, nx);
    f32x4 gnv[4];
#pragma unroll
    for (int mi = 0; mi < 4; ++mi) gnv[mi] = *(const f32x4*)(p.bng + g * 128 + wm * 64 + mi * 16 + fq * 4);
    f32x4 sacc[4][2];
#pragma unroll
    for (int mi = 0; mi < 4; ++mi) { sacc[mi][0] = (f32x4){0.f, 0.f, 0.f, 0.f}; sacc[mi][1] = (f32x4){0.f, 0.f, 0.f, 0.f}; }
#pragma unroll
    for (int ks = 0; ks < 4; ++ks) {
        bf16x8 a[4];
#pragma unroll
        for (int i = 0; i < 4; ++i) a[i] = *(const bf16x8*)(vnT + (wm * 64 + i * 16 + fr) * VNT_ROW + ks * 32 + fq * 8);
#pragma unroll
        for (int mi = 0; mi < 4; ++mi)
#pragma unroll
            for (int ni = 0; ni < 2; ++ni) sacc[mi][ni] = __builtin_amdgcn_mfma_f32_16x16x32_bf16(a[mi], o.bw[ks][ni], sacc[mi][ni], 0, 0, 0);
    }
#pragma unroll
    for (int ni = 0; ni < 2; ++ni) {
        const int tl = wn * 32 + ni * 16 + fr;
        float s2 = 0.f;
#pragma unroll
        for (int mi = 0; mi < 4; ++mi) {
            const u32x2 gv = o.guv[ni][mi];
            const float y0 = bf_lo(gv.x) * (sacc[mi][ni][0] + o.bi[ni]), y1 = bf_hi(gv.x) * (sacc[mi][ni][1] + o.bi[ni]);
            const float y2 = bf_lo(gv.y) * (sacc[mi][ni][2] + o.bi[ni]), y3 = bf_hi(gv.y) * (sacc[mi][ni][3] + o.bi[ni]);
            sacc[mi][ni] = (f32x4){y0, y1, y2, y3};
            s2 += y0 * y0 + y1 * y1 + y2 * y2 + y3 * y3;
        }
        s2 = quad_sum(s2);
        if (fq == 0) st[tl * 2 + wm] = s2;
    }
    __syncthreads();
#pragma unroll
    for (int ni = 0; ni < 2; ++ni) {
        const int tl = wn * 32 + ni * 16 + fr, tok = nb * 128 + tl;
        const float rs = rsqrtf((st[tl * 2] + st[tl * 2 + 1]) * (1.0f / 128.0f) + EPS);
#pragma unroll
        for (int mi = 0; mi < 4; ++mi) {
            const int ch = g * 128 + wm * 64 + mi * 16 + fq * 4;
            const f32x4 gn = gnv[mi];
            const u32x2 zz = o.zv[ni][mi];
            u32x2 ov;
            ov.x = pack_bf2(sacc[mi][ni][0] * rs * gn[0] * bf_lo(zz.x), sacc[mi][ni][1] * rs * gn[1] * bf_hi(zz.x));
            ov.y = pack_bf2(sacc[mi][ni][2] * rs * gn[2] * bf_lo(zz.y), sacc[mi][ni][3] * rs * gn[3] * bf_hi(zz.y));
            *(u32x2*)(p.w.mixed + (size_t)tok * 1024 + ch) = ov;
        }
    }
}

__device__ __forceinline__ void phase_sgu(const Params& p, char* smem, int tid) {
    asm volatile("" : "+v"(tid));
    const int x = blockIdx.x & 7, li = blockIdx.x >> 3;
    const bool xaw = (opaque_grid() == 256);
    if (xaw) {
        const int it = 2 * li, nb = 2 * (x + 8 * (it >> 3)) + ((it >> 2) & 1), g = it & 3;
        SguOps o0, o1;
        sgu_load(p, nb, g, tid, o0);
        sgu_compute<true>(p, nb, g, smem, tid, o0, nb, g + 1, o1);
        sgu_compute<false>(p, nb, g + 1, smem, tid, o1, 0, 0, o0);
    } else {
        for (int it = (int)blockIdx.x; it < 512; it += (int)gridDim.x) {
            SguOps o0;
            sgu_load(p, it >> 2, it & 3, tid, o0);
            sgu_compute<false>(p, it >> 2, it & 3, smem, tid, o0, 0, 0, o0);
        }
    }
}

#define LOG2E 1.4426950408889634f
__device__ __forceinline__ unsigned mono_key(float f) { const unsigned u = __float_as_uint(f); return u ^ ((unsigned)((int)u >> 31) | 0x80000000u); }
__device__ __forceinline__ int half_sum_i(int v) { v += __shfl_xor(v, 16); v += __shfl_xor(v, 8); v += __shfl_xor(v, 4); v += __shfl_xor(v, 2); v += __shfl_xor(v, 1); return v; }
__device__ __forceinline__ float half_min_f(float v) { v = fminf(v, __shfl_xor(v, 16)); v = fminf(v, __shfl_xor(v, 8)); v = fminf(v, __shfl_xor(v, 4)); v = fminf(v, __shfl_xor(v, 2)); v = fminf(v, __shfl_xor(v, 1)); return v; }

__device__ __forceinline__ void p2_item(const Params& p, int b, int qt, char* smem, int tid) {
    asm volatile("" : "+v"(tid));
    bf16_t* sK = (bf16_t*)smem;
    bf16_t* sV = sK + 2 * 64 * LROW;
    unsigned* maskL = (unsigned*)(smem + 36864);
    float* dnearL = (float*)(smem + 36864 + 8192);
    const int wv = tid >> 6, lane = tid & 63, G = lane >> 5, n = lane & 31;
    const int c = qt >> 1, nsteps = c + 1, ntiles = 2 * nsteps;
    const int tok0 = b * SEQ + qt * 32, pos0 = qt * 32;
    const int srow = tid >> 3, sch = (tid & 7) * 8;
    unsigned* mw_wave = maskL + wv * 256;
    __syncthreads();
    const int ql = n >> 3, h = n & 7;
    bf16x8 qfr[4]; u32x4 rk0, rv0; u32x2 gzp[2][4];
    const bf16_t* ksrc = p.w.kn + ((size_t)b * SEQ + srow) * 64 + sch;
    const bf16_t* vsrc = p.w.vt + ((size_t)b * 64 + srow) * SEQ + sch;
#define P2_PREFETCH() do { \
        const bf16_t* _qs = p.w.qn + (size_t)(tok0 + 4 * wv + ql) * 512 + h * 64 + 8 * G; \
        _Pragma("unroll") for (int _s = 0; _s < 4; ++_s) qfr[_s] = *(const bf16x8*)(_qs + 16 * _s); \
        rk0 = *(const u32x4*)(ksrc); rv0 = *(const u32x4*)(vsrc); } while (0)
    if (nsteps > 4) {
        bf16x8 afr[4];
        {
            const int ql = 2 * ((n >> 2) & 1) + (n >> 4), hd = 4 * ((n >> 3) & 1) + (n & 3);
            const bf16_t* src = p.w.qi + (size_t)(tok0 + 4 * wv + ql) * 512 + hd * 64 + 8 * G;
#pragma unroll
            for (int s = 0; s < 4; ++s) afr[s] = *(const bf16x8*)(src + 16 * s);
        }
        float w[16];
        {
            const float* wsrc = p.w.wi + (size_t)(tok0 + 4 * wv + 2 * G) * 8;
#pragma unroll
            for (int q4 = 0; q4 < 4; ++q4) { const f32x4 t = *(const f32x4*)(wsrc + 4 * q4); w[4 * q4] = t[0]; w[4 * q4 + 1] = t[1]; w[4 * q4 + 2] = t[2]; w[4 * q4 + 3] = t[3]; }
        }
        unsigned kk[128];
#pragma unroll
        for (int i = 0; i < 128; ++i) kk[i] = 0u;
        {
        const bf16_t* kisrc = p.w.kin + ((size_t)b * SEQ + srow) * 64 + sch;
        const bf16_t* kip = kisrc;
        u32x4 r0 = *(const u32x4*)(kisrc);
        *(u32x4*)(sK + srow * LROW + sch) = r0;
        __syncthreads();
#pragma unroll
        for (int st = 0; st < 32; ++st) {
            if (st < nsteps) {
                const bf16_t* buf = sK + (st & 1) * 64 * LROW;
                if (st + 1 < nsteps) {
                    kip += 64 * 64; asm volatile("" : "+v"(kip));
                    r0 = *(const u32x4*)(kip);
                }
                unsigned kq[2][2];
#pragma unroll
                for (int kt = 0; kt < 2; ++kt) {
                    f32x16 D;
#pragma unroll
                    for (int k = 0; k < 16; ++k) D[k] = 0.f;
#pragma unroll
                    for (int s = 0; s < 4; ++s) {
                        const bf16x8 bfr = *(const bf16x8*)(buf + (kt * 32 + n) * LROW + 16 * s + 8 * G);
                        D = __builtin_amdgcn_mfma_f32_32x32x16_bf16(afr[s], bfr, D, 0, 0, 0);
                    }
                    float s0 = 0.f, s1 = 0.f;
#pragma unroll
                    for (int k = 0; k < 8; ++k) {
                        const float r0 = __int_as_float(max(__float_as_int(D[k]), 0)), r1 = __int_as_float(max(__float_as_int(D[8 + k]), 0));
                        s0 = fmaf(w[k], r0, s0); s1 = fmaf(w[8 + k], r1, s1);
                    }
                    unsigned k0v = mono_key(s0), k1v = mono_key(s1);
                    asm volatile("" : "+v"(k0v), "+v"(k1v));
                    kq[kt][0] = k0v; kq[kt][1] = k1v;
                    __builtin_amdgcn_sched_barrier(0);
                }
#pragma unroll
                for (int a = 0; a < 2; ++a) {
                    const auto sw = __builtin_amdgcn_permlane32_swap(kq[0][a], kq[1][a], false, false);
                    kk[a * 32 + st] = sw[0];
                    kk[(2 + a) * 32 + st] = sw[1];
                }
                if (st + 1 < nsteps) {
                    bf16_t* nb = sK + ((st + 1) & 1) * 64 * LROW;
                    *(u32x4*)(nb + srow * LROW + sch) = r0;
                }
                __syncthreads();
            }
        }
        }
        P2_PREFETCH();
        {
#define SEL_COUNT(cand_, cnt_) do { unsigned a0_ = 0u, a1_ = 0u; \
            _Pragma("unroll") for (int g8 = 0; g8 < 4; ++g8) { if (g8 * 8 < nsteps) { \
                unsigned long long bm[8]; \
                asm volatile("v_cmp_ge_u32_e64 %2, %10, %18\n\tv_cmp_ge_u32_e64 %3, %11, %18\n\tv_cmp_ge_u32_e64 %4, %12, %18\n\tv_cmp_ge_u32_e64 %5, %13, %18\n\t" \
                             "v_cmp_ge_u32_e64 %6, %14, %18\n\tv_cmp_ge_u32_e64 %7, %15, %18\n\tv_cmp_ge_u32_e64 %8, %16, %18\n\tv_cmp_ge_u32_e64 %9, %17, %18\n\t" \
                             "v_addc_co_u32_e64 %0, %2, %0, 0, %2\n\tv_addc_co_u32_e64 %1, %3, %1, 0, %3\n\tv_addc_co_u32_e64 %0, %4, %0, 0, %4\n\tv_addc_co_u32_e64 %1, %5, %1, 0, %5\n\t" \
                             "v_addc_co_u32_e64 %0, %6, %0, 0, %6\n\tv_addc_co_u32_e64 %1, %7, %1, 0, %7\n\tv_addc_co_u32_e64 %0, %8, %0, 0, %8\n\tv_addc_co_u32_e64 %1, %9, %1, 0, %9" \
                             : "+v"(a0_), "+v"(a1_), "=&s"(bm[0]), "=&s"(bm[1]), "=&s"(bm[2]), "=&s"(bm[3]), "=&s"(bm[4]), "=&s"(bm[5]), "=&s"(bm[6]), "=&s"(bm[7]) \
                             : "v"(kk[q * 32 + g8 * 8 + 0]), "v"(kk[q * 32 + g8 * 8 + 1]), "v"(kk[q * 32 + g8 * 8 + 2]), "v"(kk[q * 32 + g8 * 8 + 3]), \
                               "v"(kk[q * 32 + g8 * 8 + 4]), "v"(kk[q * 32 + g8 * 8 + 5]), "v"(kk[q * 32 + g8 * 8 + 6]), "v"(kk[q * 32 + g8 * 8 + 7]), "v"(cand_)); } } \
            unsigned s_ = a0_ + a1_; \
            s_ += (unsigned)__builtin_amdgcn_update_dpp(0, (int)s_, 0x111, 0xf, 0xf, true); \
            s_ += (unsigned)__builtin_amdgcn_update_dpp(0, (int)s_, 0x112, 0xf, 0xf, true); \
            s_ += (unsigned)__builtin_amdgcn_update_dpp(0, (int)s_, 0x114, 0xf, 0xf, true); \
            s_ += (unsigned)__builtin_amdgcn_update_dpp(0, (int)s_, 0x118, 0xf, 0xf, true); \
            s_ += (unsigned)__builtin_amdgcn_update_dpp(0, (int)s_, 0x142, 0xa, 0xf, true); \
            s_ += (unsigned)__builtin_amdgcn_update_dpp(0, (int)s_, 0x143, 0xc, 0xf, true); \
            cnt_ = __builtin_amdgcn_readlane((int)s_, 63); } while (0)
#pragma unroll
        for (int q = 0; q < 4; ++q) {
            unsigned lo, hi; int clo, chi, cnt; bool exact = false;
            { const unsigned c0 = 0x80000000u; SEL_COUNT(c0, cnt); }
            const bool pos = cnt >= 256;
            unsigned mx = 0u;
            if (pos) {
#pragma unroll
                for (int g8 = 0; g8 < 4; ++g8) {
                    if (g8 * 8 < nsteps) {
#pragma unroll
                        for (int j = 0; j < 8; ++j) mx = max(mx, kk[q * 32 + g8 * 8 + j]);
                    }
                }
            } else {
#pragma unroll
                for (int g8 = 0; g8 < 4; ++g8) {
                    if (g8 * 8 < nsteps) {
#pragma unroll
                        for (int j = 0; j < 8; ++j) { const unsigned k_ = kk[q * 32 + g8 * 8 + j]; mx = max(mx, k_ & ~(unsigned)((int)k_ >> 31)); }
                    }
                }
            }
            mx = max(mx, (unsigned)__builtin_amdgcn_update_dpp(0, (int)mx, 0x111, 0xf, 0xf, true));
            mx = max(mx, (unsigned)__builtin_amdgcn_update_dpp(0, (int)mx, 0x112, 0xf, 0xf, true));
            mx = max(mx, (unsigned)__builtin_amdgcn_update_dpp(0, (int)mx, 0x114, 0xf, 0xf, true));
            mx = max(mx, (unsigned)__builtin_amdgcn_update_dpp(0, (int)mx, 0x118, 0xf, 0xf, true));
            mx = max(mx, (unsigned)__builtin_amdgcn_update_dpp(0, (int)mx, 0x142, 0xa, 0xf, true));
            mx = max(mx, (unsigned)__builtin_amdgcn_update_dpp(0, (int)mx, 0x143, 0xc, 0xf, true));
            const unsigned e = (unsigned)__builtin_amdgcn_readlane((int)mx, 63) >> 23;
            unsigned emin;
            if (pos) { lo = 0x80000000u; clo = cnt; exact = (cnt == 256); hi = (e >= 0x1ffu) ? 0xffffffffu : (e + 1u) << 23; chi = 0; emin = 0x100u; }
            else     { lo = 0u; clo = 64 * nsteps; hi = (e + 1u) << 23; chi = cnt; emin = 0u; }
            if (e > emin) {
                unsigned ec = (e - 1u > emin) ? e - 1u : e;
                for (int tries = 0; tries < 8 && !exact && ec > emin; ++tries, --ec) {
                    const unsigned cand = ec << 23;
                    SEL_COUNT(cand, cnt);
                    if (cnt >= 256) { lo = cand; clo = cnt; exact = (cnt == 256); break; }
                    hi = cand; chi = cnt;
                }
            }
            for (int it = 0; !exact && hi - lo > 1u; ++it) {
                const unsigned width = hi - lo;
                unsigned off = width >> 1;
                if (it < 12) off = (unsigned)((float)width * ((float)(clo - 256) * __builtin_amdgcn_rcpf((float)(clo - chi))));
                off = min(max(off, 1u), width - 1u);
                const unsigned cand = lo + off;
                SEL_COUNT(cand, cnt);
                if (cnt >= 256) { lo = cand; clo = cnt; exact = (cnt == 256); } else { hi = cand; chi = cnt; }
            }
            const unsigned T = lo;
            unsigned mrow = 0u;
            if (exact) {
#pragma unroll
                for (int g4 = 0; g4 < 8; ++g4) {
                    if (g4 * 4 < nsteps) {
#pragma unroll
                        for (int j = 0; j < 4; ++j) {
                            const int pp = g4 * 4 + j;
                            const unsigned long long sb = __ballot(kk[q * 32 + pp] >= T);
                            asm volatile("s_nop 1\n\tv_writelane_b32 %0, %1, %3\n\tv_writelane_b32 %0, %2, %4" : "+v"(mrow) : "s"((unsigned)sb), "s"((unsigned)(sb >> 32)), "n"(2 * pp), "n"(2 * pp + 1));
                        }
                    }
                }
            } else {
                int cg = 0;
#pragma unroll
                for (int g4 = 0; g4 < 8; ++g4) {
                    if (g4 * 4 < nsteps) {
#pragma unroll
                        for (int j = 0; j < 4; ++j) cg += __builtin_popcountll(__ballot(kk[q * 32 + g4 * 4 + j] > T));
                    }
                }
                const int need = 256 - cg;
                int run = 0;
#pragma unroll
                for (int g4 = 0; g4 < 8; ++g4) {
                    if (g4 * 4 < nsteps) {
#pragma unroll
                        for (int j = 0; j < 4; ++j) {
                            const int pp = g4 * 4 + j;
                            const unsigned key = kk[q * 32 + pp];
                            const bool eq = key == T;
                            const unsigned long long eb = __ballot(eq);
                            const int rank = run + (int)__builtin_amdgcn_mbcnt_hi((unsigned)(eb >> 32), __builtin_amdgcn_mbcnt_lo((unsigned)eb, 0u));
                            run += __builtin_popcountll(eb);
                            const unsigned long long sb = __ballot((key > T) || (eq && rank < need));
                            asm volatile("s_nop 1\n\tv_writelane_b32 %0, %1, %3\n\tv_writelane_b32 %0, %2, %4" : "+v"(mrow) : "s"((unsigned)sb), "s"((unsigned)(sb >> 32)), "n"(2 * pp), "n"(2 * pp + 1));
                        }
                    }
                }
            }
            mw_wave[q * 64 + lane] = mrow;
            const unsigned bits = mrow;
            const int qp = pos0 + 4 * wv + q, wq = qp >> 5, bq = qp & 31;
            const unsigned lo_m = (lane < wq) ? bits : ((lane == wq) ? (bits & (0xffffffffu >> (31 - bq))) : 0u);
            const unsigned hi_m = (lane > wq) ? bits : ((lane == wq) ? (bits & (0xffffffffu << bq)) : 0u);
            float d = 1e9f;
            if (lo_m) d = (float)(qp - (32 * lane + 31 - __clz((int)lo_m)));
            if (hi_m) d = fminf(d, (float)(32 * lane + (__ffs((int)hi_m) - 1) - qp));
            d = fminf(d, __shfl_xor(d, 32)); d = half_min_f(d);
            if (lane == 0) dnearL[wv * 4 + q] = d;
        }
#undef SEL_COUNT
        }
    } else {
        P2_PREFETCH();
        for (int i = lane; i < 256; i += 64) mw_wave[i] = ((i & 63) < ntiles) ? 0xffffffffu : 0u;
        if (lane < 4) dnearL[wv * 4 + lane] = 0.f;
    }
    const float slope2 = exp2f(-(float)(h + 1)) * LOG2E;
    const float qposf = (float)(pos0 + 4 * wv + ql);
    f32x16 o0, o1, ol; float l = 0.f, dn = 0.f;
#pragma unroll
    for (int dt = 0; dt < 2; ++dt)
#pragma unroll
        for (int kq = 0; kq < 4; ++kq) gzp[dt][kq] = *(const u32x2*)(p.w.gz + (size_t)(tok0 + 4 * wv + ql) * 512 + h * 64 + dt * 32 + 8 * kq + 4 * G);
    bf16x8 ones;
#pragma unroll
    for (int k = 0; k < 8; ++k) ones[k] = (short)0x3f80;
    {
    __syncthreads();
    dn = dnearL[wv * 4 + ql];
    *(u32x4*)(sK + srow * LROW + sch) = rk0;
    *(u32x4*)(sV + srow * LROW + sch) = rv0;
    __syncthreads();
#pragma unroll
    for (int k = 0; k < 16; ++k) { o0[k] = 0.f; o1[k] = 0.f; ol[k] = 0.f; }
    l = 0.f;
    for (int st = 0; st < nsteps; ++st) {
        const bf16_t* bK = sK + (st & 1) * 64 * LROW;
        const bf16_t* bV = sV + (st & 1) * 64 * LROW;
        if (st + 1 < nsteps) {
            rk0 = *(const u32x4*)(ksrc + (size_t)(st + 1) * 64 * 64);
            rv0 = *(const u32x4*)(vsrc + (st + 1) * 64);
        }
#pragma unroll
        for (int kt = 0; kt < 2; ++kt) {
            const unsigned mwsh = mw_wave[ql * 64 + 2 * st + kt] >> (4 * G);
            const float kb = (float)(st * 64 + kt * 32 + 4 * G);
            f32x16 D;
            if (st < c) {
                const float e = slope2 * (kb - qposf + dn);
#pragma unroll
                for (int k = 0; k < 16; ++k) D[k] = fmaf(slope2, (float)((k & 3) + 8 * (k >> 2)), e);
            } else {
#pragma unroll
                for (int k = 0; k < 16; ++k) D[k] = -slope2 * (fabsf(qposf - kb - (float)((k & 3) + 8 * (k >> 2))) - dn);
            }
#pragma unroll
            for (int s = 0; s < 4; ++s) {
                const bf16x8 kfr = *(const bf16x8*)(bK + (kt * 32 + n) * LROW + 16 * s + 8 * G);
                D = __builtin_amdgcn_mfma_f32_32x32x16_bf16(kfr, qfr[s], D, 0, 0, 0);
            }
            unsigned pk[8];
#pragma unroll
            for (int k2 = 0; k2 < 8; ++k2) {
                float pe[2];
#pragma unroll
                for (int u = 0; u < 2; ++u) {
                    const int k = 2 * k2 + u, ck = (k & 3) + 8 * (k >> 2);
                    const float e = __builtin_amdgcn_exp2f(D[k]);
                    const int m = __builtin_amdgcn_sbfe((int)mwsh, ck, 1);
                    pe[u] = __uint_as_float(__float_as_uint(e) & (unsigned)m);
                }
                pk[k2] = pack_bf2(pe[0], pe[1]);
            }
            bf16x8 pf[2];
#pragma unroll
            for (int ks = 0; ks < 2; ++ks) {
                u32x4 t; t.x = pk[4 * ks]; t.y = pk[4 * ks + 1]; t.z = pk[4 * ks + 2]; t.w = pk[4 * ks + 3];
                pf[ks] = __builtin_bit_cast(bf16x8, t);
            }
#pragma unroll
            for (int ks = 0; ks < 2; ++ks) {
                const bf16x8 v0 = *(const bf16x8*)(bV + n * LROW + (2 * kt + ks) * 16 + 8 * G);
                const bf16x8 v1 = *(const bf16x8*)(bV + (32 + n) * LROW + (2 * kt + ks) * 16 + 8 * G);
                o0 = __builtin_amdgcn_mfma_f32_32x32x16_bf16(v0, pf[ks], o0, 0, 0, 0);
                o1 = __builtin_amdgcn_mfma_f32_32x32x16_bf16(v1, pf[ks], o1, 0, 0, 0);
                ol = __builtin_amdgcn_mfma_f32_32x32x16_bf16(ones, pf[ks], ol, 0, 0, 0);
            }
        }
        if (st + 1 < nsteps) {
            bf16_t* nK = sK + ((st + 1) & 1) * 64 * LROW; bf16_t* nV = sV + ((st + 1) & 1) * 64 * LROW;
            *(u32x4*)(nK + srow * LROW + sch) = rk0;
            *(u32x4*)(nV + srow * LROW + sch) = rv0;
        }
        __syncthreads();
    }
    }
    l = ol[0];
    const float il = 1.0f / l;
    float ss = 0.f;
#pragma unroll
    for (int k = 0; k < 16; ++k) { o0[k] *= il; o1[k] *= il; ss += o0[k] * o0[k] + o1[k] * o1[k]; }
    ss += __shfl_xor(ss, 32);
    const float rs = rsqrtf(ss * (1.0f / 64.0f) + EPS);
    bf16_t* oimg = (bf16_t*)(smem + 49152) + wv * (4 * 8 * 72);
#pragma unroll
    for (int dt = 0; dt < 2; ++dt)
#pragma unroll
        for (int kq = 0; kq < 4; ++kq) {
            const int d0 = dt * 32 + 8 * kq + 4 * G;
            const f32x4 gn = *(const f32x4*)(p.bng + 512 + h * 64 + d0);
            const u32x2 gzv = gzp[dt][kq];
            const float z0 = __uint_as_float(gzv.x << 16), z1 = __uint_as_float(gzv.x & 0xffff0000u), z2 = __uint_as_float(gzv.y << 16), z3 = __uint_as_float(gzv.y & 0xffff0000u);
            const float y0 = (dt ? o1[4 * kq] : o0[4 * kq]) * rs * gn[0] * z0, y1 = (dt ? o1[4 * kq + 1] : o0[4 * kq + 1]) * rs * gn[1] * z1;
            const float y2 = (dt ? o1[4 * kq + 2] : o0[4 * kq + 2]) * rs * gn[2] * z2, y3 = (dt ? o1[4 * kq + 3] : o0[4 * kq + 3]) * rs * gn[3] * z3;
            u32x2 o; o.x = pack_bf2(y0, y1); o.y = pack_bf2(y2, y3);
            *(u32x2*)(oimg + (ql * 8 + h) * 72 + d0) = o;
        }
#pragma unroll
    for (int q = 0; q < 4; ++q) {
        const u32x4 t = *(const u32x4*)(oimg + (q * 8 + (lane >> 3)) * 72 + (lane & 7) * 8);
        *(u32x4*)(p.w.mixed + (size_t)(tok0 + 4 * wv + q) * 1024 + 512 + lane * 8) = t;
    }
}

__device__ __forceinline__ void phase2(const Params& p, char* smem, int tid) {
    const int Gn = gridDim.x, bi = blockIdx.x;
    for (int rd = 0;; ++rd) {
        const int rank = rd * Gn + ((rd & 1) ? (Gn - 1 - bi) : bi);
        if (rank >= 512) break;
        const int c = 31 - (rank >> 4), j = rank & 15;
        p2_item(p, j >> 1, c * 2 + (j & 1), smem, tid);
    }
}

__device__ __forceinline__ void phase3(const Params& p, char* smem, int tid) {
    const bool xaw = (opaque_grid() == 256);
    for (int r = 0;; ++r) {
        int u;
        if (xaw) { if (r) break; u = ((blockIdx.x & 7) + 8 * (blockIdx.x >> 5)) * 4 + ((blockIdx.x >> 3) & 3); }
        else { u = blockIdx.x + r * gridDim.x; if (u >= 256) break; }
        const int tb = u >> 2, cb = u & 3;
        f32x4 acc[8][4];
        gemm_ring256(p.w.WoutT + (size_t)cb * 256 * DM, p.w.mixed + (size_t)tb * 256 * DM, smem, acc, tid);
        asm volatile("" : "+v"(tid));
        const int wv = tid >> 6, lane = tid & 63, wm = wv >> 2, wn = wv & 3, fr = lane & 15, fq = lane >> 4;
        float* img = (float*)(smem + wv * 16896);
        __syncthreads();
        const size_t gbase = (size_t)(tb * 256 + wn * 64) * DM + cb * 256 + wm * 128 + (lane & 31) * 4;
#pragma unroll
        for (int hf = 0; hf < 2; ++hf) {
#pragma unroll
            for (int n2 = 0; n2 < 2; ++n2)
#pragma unroll
                for (int mi = 0; mi < 8; ++mi) *(f32x4*)(img + (n2 * 16 + fr) * 132 + mi * 16 + fq * 4) = acc[mi][hf * 2 + n2];
#pragma unroll
            for (int bt = 0; bt < 2; ++bt) {
                f32x4 xv[8];
#pragma unroll
                for (int ps = 0; ps < 8; ++ps) {
                    const int row = (bt * 8 + ps) * 2 + (lane >> 5);
                    xv[ps] = __builtin_nontemporal_load((const f32x4*)(p.x + gbase + (size_t)(hf * 32 + row) * DM));
                }
#pragma unroll
                for (int ps = 0; ps < 8; ++ps) {
                    const int row = (bt * 8 + ps) * 2 + (lane >> 5);
                    const f32x4 t = *(const f32x4*)(img + row * 132 + (lane & 31) * 4);
                    __builtin_nontemporal_store(xv[ps] + t, (f32x4*)(p.out + gbase + (size_t)(hf * 32 + row) * DM));
                }
            }
        }
    }
}

#define XB_TMO      128
#define XB_XCNT(j)  (256  + 64 * (j))
#define XB_XSUB(j)  (1280 + 64 * (j))
#define XB_XGEN(j)  (2304 + 64 * (j))
#define XB_TOP      3328
#define XB_TOPGEN   3392
#define XCD_BAR_WORDS 3456
#define XB_SPIN_CAP (1u << 18)
#define XLAS __attribute__((address_space(3)))
__device__ __forceinline__ unsigned xb_ld(unsigned* p)              { return __hip_atomic_load(p, __ATOMIC_RELAXED, __HIP_MEMORY_SCOPE_AGENT); }
__device__ __forceinline__ unsigned xb_add(unsigned* p, unsigned v) { return __hip_atomic_fetch_add(p, v, __ATOMIC_RELAXED, __HIP_MEMORY_SCOPE_AGENT); }
__device__ __forceinline__ unsigned xb_xcc_id() { return (unsigned)__builtin_amdgcn_s_getreg((3 << 11) | 20) & 0xFu; }
#define XB_SPIN(cond, bar) do { unsigned _sp = 0; while (cond) { __builtin_amdgcn_s_sleep(1); \
    if ((++_sp & 255u) == 0u) { if (xb_ld(&(bar)[XB_TMO])) break; if (_sp > XB_SPIN_CAP) { atomicAdd(&(bar)[XB_TMO], 1u); break; } } } } while (0)
struct XcdBarrier { unsigned* bar; unsigned x; volatile XLAS unsigned* st; };
__device__ __forceinline__ XcdBarrier xcd_barrier_post(unsigned* bar, volatile XLAS unsigned* st) {
    XcdBarrier b; b.bar = bar; b.x = xb_xcc_id(); b.st = st;
    if (threadIdx.x == 0) (void)xb_add(&bar[XB_XCNT(b.x)], 1u);
    return b;
}
__device__ __forceinline__ void xcd_barrier_complete(unsigned* bar, unsigned x, unsigned& nloc, unsigned& nx) {
    const unsigned G = gridDim.x * gridDim.y * gridDim.z;
    unsigned sum, cnt, mine, sp = 0u;
    for (;;) {
        sum = 0u; cnt = 0u; mine = 0u;
#pragma unroll
        for (unsigned j = 0; j < 16; ++j) { const unsigned c = xb_ld(&bar[XB_XCNT(j)]); sum += c; cnt += (c > 0u) ? 1u : 0u; mine = (j == x) ? c : mine; }
        if (sum == G) break;
        __builtin_amdgcn_s_sleep(1);
        if ((++sp & 255u) == 0u) { if (xb_ld(&bar[XB_TMO])) break; if (sp > XB_SPIN_CAP) { atomicAdd(&bar[XB_TMO], 1u); break; } }
    }
    nloc = mine > 0u ? mine : 1u; nx = cnt > 0u ? cnt : 1u;
}
__device__ __forceinline__ void xcd_barrier(const XcdBarrier& b) {
    asm volatile("s_waitcnt vmcnt(0)" ::: "memory");
    __syncthreads();
    int t0 = threadIdx.x; asm volatile("" : "+v"(t0));
    if (t0 == 0) {
        unsigned* bar = b.bar;
        __builtin_amdgcn_s_waitcnt(0);
        unsigned nloc = b.st[0], nx = b.st[1];
        if (nloc == 0u) { xcd_barrier_complete(bar, b.x, nloc, nx); b.st[0] = nloc; b.st[1] = nx; }
        const unsigned old = xb_add(&bar[XB_XSUB(b.x)], 1u);
        const unsigned gen = old / nloc;
        if (old + 1u == (gen + 1u) * nloc) {
            __builtin_amdgcn_fence(__ATOMIC_RELEASE, "agent");
            asm volatile("s_waitcnt vmcnt(0)" ::: "memory");
            const unsigned og = xb_add(&bar[XB_TOP], 1u);
            const unsigned tg = og / nx;
            if (og + 1u == (tg + 1u) * nx) xb_add(&bar[XB_TOPGEN], 1u);
            else XB_SPIN(xb_ld(&bar[XB_TOPGEN]) == tg, bar);
            __builtin_amdgcn_fence(__ATOMIC_ACQUIRE, "agent");
            xb_add(&bar[XB_XGEN(b.x)], 1u);
            asm volatile("s_waitcnt vmcnt(0)" ::: "memory");
        } else {
            XB_SPIN(xb_ld(&bar[XB_XGEN(b.x)]) == gen, bar);
            __builtin_amdgcn_fence(__ATOMIC_ACQUIRE, "agent");
            asm volatile("s_waitcnt vmcnt(0)" ::: "memory");
        }
    }
    __syncthreads();
}

__global__ void __launch_bounds__(NT, 2) mega_kernel(Params p, int mask) {
    __shared__ __attribute__((aligned(16))) char smem[SMEM_BYTES + 16];
    cg::grid_group grid = cg::this_grid();
    int tid = threadIdx.x;
    volatile XLAS unsigned* xst = (volatile XLAS unsigned*)(smem + SMEM_BYTES);
    if (tid < 4) xst[tid] = 0u;
    __syncthreads();
    const XcdBarrier xb = xcd_barrier_post(p.w.bar, xst);
    if (mask) grid.sync();
    phase0<0>(p, smem, tid, (int)blockIdx.x, (int)gridDim.x); xcd_barrier(xb);
    phase1(p, smem, tid);    xcd_barrier(xb);
    phase_sgu(p, smem, tid);
    phase2(p, smem, tid);    xcd_barrier(xb);
    phase3(p, smem, tid);
}

extern "C" void kernel_launch(void* const* d_in, const int* in_sizes, int n_in, void* d_out, int out_size, void* d_ws, size_t ws_size,
                              hipStream_t stream) {
    const float* x = (const float*)d_in[0];
    const float* norm_gain = (const float*)d_in[1];
    const float* w_in = (const float*)d_in[2];
    const float* sgu_ng = (const float*)d_in[3];
    const float* sgu_w = (const float*)d_in[4];
    const float* sgu_b = (const float*)d_in[5];
    const float* qg = (const float*)d_in[6];
    const float* kg = (const float*)d_in[7];
    const float* ikg = (const float*)d_in[8];
    const float* bng = (const float*)d_in[9];
    const float* w_out = (const float*)d_in[10];
    float* out = (float*)d_out;
    WS w = make_ws(d_ws);
    Params p{};
    p.x = x; p.norm_gain = norm_gain; p.w_in = w_in; p.sgu_ng = sgu_ng; p.sgu_w = sgu_w; p.sgu_b = sgu_b;
    p.qg = qg; p.kg = kg; p.ikg = ikg; p.bng = bng; p.w_out = w_out; p.out = out; p.w = w;
    static int grid_blocks = 0;
    if (!grid_blocks) {
        int dev = 0, cus = 0, per_cu = 0;
        (void)hipGetDevice(&dev);
        (void)hipDeviceGetAttribute(&cus, hipDeviceAttributeMultiprocessorCount, dev);
        (void)hipOccupancyMaxActiveBlocksPerMultiprocessor(&per_cu, mega_kernel, NT, 0);
        if (per_cu > 1) per_cu = 1;
        if (per_cu < 1) per_cu = 1;
        grid_blocks = cus * per_cu;
    }
    int mask1 = 0;
    (void)hipMemsetAsync(w.bar, 0, (size_t)4096 * 4, stream);
    {
        void* args[] = {&p, &mask1};
        hipError_t e = hipLaunchCooperativeKernel((void*)mega_kernel, dim3(grid_blocks), dim3(NT), args, 0, stream);
        if (e != hipSuccess) fprintf(stderr, "cooperative launch failed: %s (grid %d)\n", hipGetErrorString(e), grid_blocks);
    }
}
```

```cpp
#include <hip/hip_runtime.h>
#include <hip/hip_cooperative_groups.h>
#include <stdint.h>
#include <cstdio>
namespace cg = cooperative_groups;

typedef unsigned short bf16_t;
typedef short bf16x8 __attribute__((ext_vector_type(8)));
typedef float f32x4 __attribute__((ext_vector_type(4)));
typedef float f32x16 __attribute__((ext_vector_type(16)));
typedef unsigned u32x4 __attribute__((ext_vector_type(4)));
typedef unsigned u32x2 __attribute__((ext_vector_type(2)));

#define T_TOK 16384
#define SEQ 2048
#define NB 8
#define DM 1024
#define DIN 3272
#define EPS 1e-6f

__device__ __forceinline__ float bf2f(bf16_t v) { return __uint_as_float(((unsigned)v) << 16); }
__device__ __forceinline__ bf16_t f2bf(float f) {
    unsigned u = __float_as_uint(f);
    u += 0x7fffu + ((u >> 16) & 1u);
    return (bf16_t)(u >> 16);
}
__device__ __forceinline__ float gelu_tanh(float x) {
    const float t = x * x * 0.044715f + 1.0f;
    const float e = __builtin_amdgcn_exp2f(x * t * (-2.0f * 0.7978845608028654f * 1.4426950408889634f));
    return x * __builtin_amdgcn_rcpf(1.0f + e);
}
__device__ __forceinline__ float silu_f(float x) { return x * __builtin_amdgcn_rcpf(1.0f + __builtin_amdgcn_exp2f(x * -1.4426950408889634f)); }
__device__ __forceinline__ float wave_sum(float v) {
#pragma unroll
    for (int o = 32; o >= 1; o >>= 1) v += __shfl_xor(v, o);
    return v;
}
__device__ __forceinline__ int perm16(int k) { return k < 4 ? k : (k < 8 ? k + 4 : (k < 12 ? k - 4 : k)); }
__device__ __forceinline__ int vt_pos(int s) { return (s & ~15) | perm16(s & 15); }

struct WS {
    bf16_t* qn;
    bf16_t* qi;
    bf16_t* gz;
    bf16_t* mixed;
    bf16_t* kn;
    bf16_t* kin;
    bf16_t* vt;
    float* wi;
    float* rinv;
    bf16_t* xb;
    bf16_t* WinT;
    bf16_t* WoutT;
    bf16_t* Wm;
    bf16_t* gu;
    bf16_t* vn;
    bf16_t* gza;
    unsigned* bar;
};
static WS make_ws(void* d_ws) {
    char* p = (char*)d_ws; WS w;
    auto take = [&](size_t bytes) { char* r = p; p += (bytes + 255) & ~(size_t)255; return r; };
    w.qn = (bf16_t*)take((size_t)T_TOK * 512 * 2);
    w.qi = (bf16_t*)take((size_t)T_TOK * 512 * 2);
    w.gz = (bf16_t*)take((size_t)T_TOK * 512 * 2);
    w.mixed = (bf16_t*)take((size_t)T_TOK * 1024 * 2);
    w.kn = (bf16_t*)take((size_t)T_TOK * 64 * 2);
    w.kin = (bf16_t*)take((size_t)T_TOK * 64 * 2);
    w.vt = (bf16_t*)take((size_t)T_TOK * 64 * 2);
    w.wi = (float*)take((size_t)T_TOK * 8 * 4);
    w.rinv = (float*)take((size_t)T_TOK * 4);
    w.xb = (bf16_t*)take((size_t)T_TOK * 1024 * 2);
    w.WinT = (bf16_t*)take((size_t)3328 * 1024 * 2);
    w.WoutT = (bf16_t*)take((size_t)1024 * 1024 * 2);
    w.Wm = (bf16_t*)take((size_t)4 * 128 * 128 * 2);
    w.gu = (bf16_t*)take((size_t)T_TOK * 512 * 2);
    w.vn = (bf16_t*)take((size_t)T_TOK * 512 * 2);
    w.gza = (bf16_t*)take((size_t)T_TOK * 512 * 2);
    w.bar = (unsigned*)take((size_t)4096 * 4);
    return w;
}

#define LAS __attribute__((address_space(3)))
#define NT 512
#define LROW 72
#define RING_STAGE 49152
#define RING_BYTES (3 * RING_STAGE)
#define ST_OFF RING_BYTES
#define SMEM_BYTES (RING_BYTES + 4096)

struct Params {
    const float* x; const float* norm_gain; const float* w_in; const float* sgu_ng; const float* sgu_w; const float* sgu_b;
    const float* qg; const float* kg; const float* ikg; const float* bng; const float* w_out; float* out;
    WS w;
};

typedef float f32x2 __attribute__((ext_vector_type(2)));
typedef __bf16 hbf16x2 __attribute__((ext_vector_type(2)));
__device__ __forceinline__ unsigned pack_bf2(float lo, float hi) {
    const f32x2 v = {lo, hi};
    return __builtin_bit_cast(unsigned, __builtin_convertvector(v, hbf16x2));
}
__device__ __forceinline__ float bf_lo(unsigned u) { return __uint_as_float(u << 16); }
__device__ __forceinline__ float bf_hi(unsigned u) { return __uint_as_float(u & 0xffff0000u); }

__device__ __forceinline__ int opaque_grid() { int g = (int)gridDim.x; asm volatile("" : "+s"(g)); return g; }
#define GWAIT_V(n) asm volatile("s_waitcnt vmcnt(" #n ")" ::: "memory")
#define GBAR() do { __builtin_amdgcn_s_barrier(); asm volatile("" ::: "memory"); } while (0)
__device__ __forceinline__ void gemm_ring(const bf16_t* __restrict__ Wt, const bf16_t* __restrict__ Xt, char* smem, f32x4 (&acc)[4][4], int tid,
                                          int st0 = 0, int pre = 0, const bf16_t* __restrict__ nWt = nullptr, const bf16_t* __restrict__ nXt = nullptr) {
    const int wv = __builtin_amdgcn_readfirstlane(tid >> 6), lane = tid & 63, wm = wv >> 2, wn = wv & 3, fr = lane & 15, fq = lane >> 4;
    LAS char* lds = (LAS char*)smem;
    const int sc = (lane & 7) ^ ((((wv & 1) << 2) + (lane >> 4)) & 7);
    const bf16_t* gX = Xt + (size_t)(wv * 8 + (lane >> 3)) * DM + sc * 8;
    const bf16_t* gW = Wt + (size_t)(wv * 8 + (lane >> 3)) * DM + sc * 8;
    const bool has_next = nWt != nullptr;
    const bf16_t* gX2 = (has_next ? nXt : Xt) + (size_t)(wv * 8 + (lane >> 3)) * DM + sc * 8;
    const bf16_t* gW2 = (has_next ? nWt : Wt) + (size_t)(wv * 8 + (lane >> 3)) * DM + sc * 8;
#define GSTAGE_N(st, k0) do { LAS char* _b = lds + (st) * RING_STAGE + wv * 1024; \
        _Pragma("unroll") for (int _i = 0; _i < 4; ++_i) __builtin_amdgcn_global_load_lds((const unsigned*)(gX2 + (size_t)_i * 64 * DM + (k0)), (LAS unsigned*)(_b + _i * 8192), 16, 0, 0); \
        _Pragma("unroll") for (int _i = 0; _i < 2; ++_i) __builtin_amdgcn_global_load_lds((const unsigned*)(gW2 + (size_t)_i * 64 * DM + (k0)), (LAS unsigned*)(_b + 32768 + _i * 8192), 16, 0, 0); } while (0)
#define GSTAGE(st, k0) do { LAS char* _b = lds + (st) * RING_STAGE + wv * 1024; \
        _Pragma("unroll") for (int _i = 0; _i < 4; ++_i) __builtin_amdgcn_global_load_lds((const unsigned*)(gX + (size_t)_i * 64 * DM + (k0)), (LAS unsigned*)(_b + _i * 8192), 16, 0, 0); \
        _Pragma("unroll") for (int _i = 0; _i < 2; ++_i) __builtin_amdgcn_global_load_lds((const unsigned*)(gW + (size_t)_i * 64 * DM + (k0)), (LAS unsigned*)(_b + 32768 + _i * 8192), 16, 0, 0); } while (0)
    const int sl0 = ((fq) ^ (fr >> 1)) << 4, sl1 = ((4 + fq) ^ (fr >> 1)) << 4;
    const int offX = wn * 8192 + fr * 128, offW = 32768 + wm * 8192 + fr * 128;
#pragma unroll
    for (int mi = 0; mi < 4; ++mi)
#pragma unroll
        for (int ni = 0; ni < 4; ++ni) acc[mi][ni] = (f32x4){0.f, 0.f, 0.f, 0.f};
    const int s1 = (st0 == 2) ? 0 : st0 + 1, s2 = (s1 == 2) ? 0 : s1 + 1;
    GWAIT_V(0);
    GBAR();
    if (pre == 0) GSTAGE(st0, 0);
    if (pre != 1) GSTAGE(s1, 64);
    GSTAGE(s2, 128);
    bf16x8 A0[4], B0[4], A1[4], B1[4];
#define GLDFRAG(A_, B_, sb_, sl_) do { _Pragma("unroll") for (int _i = 0; _i < 4; ++_i) { \
        A_[_i] = *(const LAS bf16x8*)((sb_) + offW + _i * 2048 + (sl_)); B_[_i] = *(const LAS bf16x8*)((sb_) + offX + _i * 2048 + (sl_)); } } while (0)
#define GMMA(A_, B_) do { _Pragma("unroll") for (int _m = 0; _m < 4; ++_m) _Pragma("unroll") for (int _n = 0; _n < 4; ++_n) \
        acc[_m][_n] = __builtin_amdgcn_mfma_f32_16x16x32_bf16(A_[_m], B_[_n], acc[_m][_n], 0, 0, 0); } while (0)
#define GMMA_ROW(A_, B_, m_) do { __builtin_amdgcn_s_setprio(1); _Pragma("unroll") for (int _n = 0; _n < 4; ++_n) \
        acc[m_][_n] = __builtin_amdgcn_mfma_f32_16x16x32_bf16(A_[m_], B_[_n], acc[m_][_n], 0, 0, 0); __builtin_amdgcn_s_setprio(0); } while (0)
    if (pre == 0) { GWAIT_V(12); GBAR(); }
    GLDFRAG(A0, B0, lds + st0 * RING_STAGE, sl0);
    int st = st0;
    for (int kt = 0; kt < 16; ++kt) {
        const LAS char* sb = lds + st * RING_STAGE;
        const int sn = (st == 2) ? 0 : st + 1;
        GMMA_ROW(A0, B0, 0);
        __builtin_amdgcn_sched_barrier(0);
        GLDFRAG(A1, B1, sb, sl1);
        __builtin_amdgcn_sched_barrier(0);
        GMMA_ROW(A0, B0, 1); GMMA_ROW(A0, B0, 2); GMMA_ROW(A0, B0, 3);
        __builtin_amdgcn_sched_barrier(0);
        if (kt < 15) {
            if (kt < 14 || has_next) GWAIT_V(6); else GWAIT_V(0);
            asm volatile("s_waitcnt lgkmcnt(0)" ::: "memory");
            GBAR();
            if (wv < 4) {
                if (kt + 3 < 16) GSTAGE(st, (kt + 3) * 64);
                else if (has_next) GSTAGE_N(st, (kt - 13) * 64);
            }
        }
        GMMA_ROW(A1, B1, 0);
        __builtin_amdgcn_sched_barrier(0);
        if (kt < 15) GLDFRAG(A0, B0, lds + sn * RING_STAGE, sl0);
        __builtin_amdgcn_sched_barrier(0);
        GMMA_ROW(A1, B1, 1); GMMA_ROW(A1, B1, 2); GMMA_ROW(A1, B1, 3);
        __builtin_amdgcn_sched_barrier(0);
        if (wv >= 4 && kt < 15) {
            if (kt + 3 < 16) GSTAGE(st, (kt + 3) * 64);
            else if (has_next) GSTAGE_N(st, (kt - 13) * 64);
        }
        __builtin_amdgcn_sched_barrier(0);
        st = sn;
    }
#undef GMMA_ROW
#undef GLDFRAG
#undef GMMA
#undef GSTAGE
#undef GSTAGE_N
}

#define R2_STAGE 65536
__device__ __forceinline__ void gemm_ring256(const bf16_t* __restrict__ Wt, const bf16_t* __restrict__ Xt, char* smem, f32x4 (&acc)[8][4], int tid, bool pre = false) {
    const int wv = __builtin_amdgcn_readfirstlane(tid >> 6), lane = tid & 63, wm = wv >> 2, wn = wv & 3, fr = lane & 15, fq = lane >> 4;
    LAS char* lds = (LAS char*)smem;
    const int sc = (lane & 7) ^ ((((wv & 1) << 2) + (lane >> 4)) & 7);
    const bf16_t* gX = Xt + (size_t)(wv * 8 + (lane >> 3)) * DM + sc * 8;
    const bf16_t* gW = Wt + (size_t)(wv * 8 + (lane >> 3)) * DM + sc * 8;
#define G2STAGE(st, k0) do { LAS char* _b = lds + (st) * R2_STAGE + wv * 1024; \
        _Pragma("unroll") for (int _i = 0; _i < 4; ++_i) __builtin_amdgcn_global_load_lds((const unsigned*)(gX + (size_t)_i * 64 * DM + (k0)), (LAS unsigned*)(_b + _i * 8192), 16, 0, 0); \
        _Pragma("unroll") for (int _i = 0; _i < 4; ++_i) __builtin_amdgcn_global_load_lds((const unsigned*)(gW + (size_t)_i * 64 * DM + (k0)), (LAS unsigned*)(_b + 32768 + _i * 8192), 16, 0, 0); } while (0)
    const int sl0 = ((fq) ^ (fr >> 1)) << 4, sl1 = ((4 + fq) ^ (fr >> 1)) << 4;
    const int offX = wn * 8192 + fr * 128, offW = 32768 + wm * 16384 + fr * 128;
#pragma unroll
    for (int mi = 0; mi < 8; ++mi)
#pragma unroll
        for (int ni = 0; ni < 4; ++ni) acc[mi][ni] = (f32x4){0.f, 0.f, 0.f, 0.f};
    GWAIT_V(0);
    GBAR();
    if (!pre) G2STAGE(0, 0);
    G2STAGE(1, 64);
    bf16x8 A0[8], B0[4], A1[8], B1[4];
#define G2LDFRAG(A_, B_, sb_, sl_) do { _Pragma("unroll") for (int _i = 0; _i < 8; ++_i) A_[_i] = *(const LAS bf16x8*)((sb_) + offW + _i * 2048 + (sl_)); \
        _Pragma("unroll") for (int _i = 0; _i < 4; ++_i) B_[_i] = *(const LAS bf16x8*)((sb_) + offX + _i * 2048 + (sl_)); } while (0)
#define G2MMA_ROW(A_, B_, m_) do { __builtin_amdgcn_s_setprio(1); _Pragma("unroll") for (int _n = 0; _n < 4; ++_n) \
        acc[m_][_n] = __builtin_amdgcn_mfma_f32_16x16x32_bf16(A_[m_], B_[_n], acc[m_][_n], 0, 0, 0); __builtin_amdgcn_s_setprio(0); } while (0)
    if (!pre) { GWAIT_V(8); GBAR(); }
    G2LDFRAG(A0, B0, lds, sl0);
    for (int kt = 0; kt < 16; ++kt) {
        const int s = kt & 1;
        const LAS char* sb = lds + s * R2_STAGE;
        G2MMA_ROW(A0, B0, 0);
        __builtin_amdgcn_sched_barrier(0);
        G2LDFRAG(A1, B1, sb, sl1);
        __builtin_amdgcn_sched_barrier(0);
        G2MMA_ROW(A0, B0, 1); G2MMA_ROW(A0, B0, 2); G2MMA_ROW(A0, B0, 3); G2MMA_ROW(A0, B0, 4); G2MMA_ROW(A0, B0, 5); G2MMA_ROW(A0, B0, 6); G2MMA_ROW(A0, B0, 7);
        __builtin_amdgcn_sched_barrier(0);
        if (kt < 15) {
            GWAIT_V(0);
            asm volatile("s_waitcnt lgkmcnt(0)" ::: "memory");
            GBAR();
            if (kt + 2 < 16 && wv < 4) G2STAGE(s, (kt + 2) * 64);
        }
        G2MMA_ROW(A1, B1, 0);
        __builtin_amdgcn_sched_barrier(0);
        if (kt < 15) G2LDFRAG(A0, B0, lds + (s ^ 1) * R2_STAGE, sl0);
        __builtin_amdgcn_sched_barrier(0);
        G2MMA_ROW(A1, B1, 1); G2MMA_ROW(A1, B1, 2); G2MMA_ROW(A1, B1, 3); G2MMA_ROW(A1, B1, 4); G2MMA_ROW(A1, B1, 5); G2MMA_ROW(A1, B1, 6); G2MMA_ROW(A1, B1, 7);
        __builtin_amdgcn_sched_barrier(0);
        if (kt + 2 < 16 && wv >= 4) G2STAGE(s, (kt + 2) * 64);
        __builtin_amdgcn_sched_barrier(0);
    }
#undef G2MMA_ROW
#undef G2LDFRAG
#undef G2STAGE
}

__device__ __forceinline__ void g2_prefetch0(const bf16_t* __restrict__ Wt, const bf16_t* __restrict__ Xt, char* smem, int tid) {
    const int wv = __builtin_amdgcn_readfirstlane(tid >> 6), lane = tid & 63;
    LAS char* lds = (LAS char*)smem;
    const int sc = (lane & 7) ^ ((((wv & 1) << 2) + (lane >> 4)) & 7);
    const bf16_t* gX = Xt + (size_t)(wv * 8 + (lane >> 3)) * DM + sc * 8;
    const bf16_t* gW = Wt + (size_t)(wv * 8 + (lane >> 3)) * DM + sc * 8;
    LAS char* b = lds + wv * 1024;
#pragma unroll
    for (int i = 0; i < 4; ++i) __builtin_amdgcn_global_load_lds((const unsigned*)(gX + (size_t)i * 64 * DM), (LAS unsigned*)(b + i * 8192), 16, 0, 0);
#pragma unroll
    for (int i = 0; i < 4; ++i) __builtin_amdgcn_global_load_lds((const unsigned*)(gW + (size_t)i * 64 * DM), (LAS unsigned*)(b + 32768 + i * 8192), 16, 0, 0);
}

__device__ __forceinline__ void g1_prefetch0(const bf16_t* __restrict__ Wt, const bf16_t* __restrict__ Xt, char* smem, int tid) {
    const int wv = __builtin_amdgcn_readfirstlane(tid >> 6), lane = tid & 63;
    LAS char* lds = (LAS char*)smem;
    const int sc = (lane & 7) ^ ((((wv & 1) << 2) + (lane >> 4)) & 7);
    const bf16_t* gX = Xt + (size_t)(wv * 8 + (lane >> 3)) * DM + sc * 8;
    const bf16_t* gW = Wt + (size_t)(wv * 8 + (lane >> 3)) * DM + sc * 8;
    LAS char* b = lds + wv * 1024;
#pragma unroll
    for (int i = 0; i < 4; ++i) __builtin_amdgcn_global_load_lds((const unsigned*)(gX + (size_t)i * 64 * DM), (LAS unsigned*)(b + i * 8192), 16, 0, 0);
#pragma unroll
    for (int i = 0; i < 2; ++i) __builtin_amdgcn_global_load_lds((const unsigned*)(gW + (size_t)i * 64 * DM), (LAS unsigned*)(b + 32768 + i * 8192), 16, 0, 0);
}

__device__ __forceinline__ void transpose_tile(const float* __restrict__ src, int ld_src, int ncols_valid, const float* __restrict__ gain, bf16_t* __restrict__ dst,
                               int k0, int e0, float* tile  , int tid) {
    __syncthreads();
    f32x4 v[4];
#pragma unroll
    for (int p = 0; p < 4; ++p) {
        const int k = p * 16 + (tid >> 5), e = (tid & 31) * 4;
        const float* s = src + (size_t)(k0 + k) * ld_src + e0 + e;
        if (e0 + e + 3 < ncols_valid) v[p] = __builtin_nontemporal_load((const f32x4*)s);
        else { v[p] = (f32x4){0.f, 0.f, 0.f, 0.f};
#pragma unroll
            for (int i = 0; i < 4; ++i) if (e0 + e + i < ncols_valid) v[p][i] = s[i]; }
    }
#pragma unroll
    for (int p = 0; p < 4; ++p) {
        const int k = p * 16 + (tid >> 5), e = (tid & 31) * 4;
        const float g = gain ? gain[k0 + k] : 1.0f;
        *(f32x4*)(tile + k * 132 + e) = v[p] * g;
    }
    __syncthreads();
#pragma unroll
    for (int p = 0; p < 2; ++p) {
        const int e = (tid >> 3) + 64 * p, c = (tid & 7) * 8;
        u32x4 o;
        o.x = pack_bf2(tile[(c + 0) * 132 + e], tile[(c + 1) * 132 + e]);
        o.y = pack_bf2(tile[(c + 2) * 132 + e], tile[(c + 3) * 132 + e]);
        o.z = pack_bf2(tile[(c + 4) * 132 + e], tile[(c + 5) * 132 + e]);
        o.w = pack_bf2(tile[(c + 6) * 132 + e], tile[(c + 7) * 132 + e]);
        *(u32x4*)(dst + (size_t)(e0 + e) * 1024 + k0 + c) = o;
    }
}
template <int MODE>
__device__ __forceinline__ void phase0(const Params& p, char* smem, int tid, int i0, int di) {
    asm volatile("" : "+v"(tid));
    const int wv = tid >> 6, lane = tid & 63;
    const int N_TIN = 16 * 26, N_TOUT = 16 * 8, N_WM = 32, N_ROWS = T_TOK / 32;
    const int total = MODE == 0 ? N_TIN + N_ROWS : N_TOUT + N_WM;
    for (int it0 = i0; it0 < total; it0 += di) {
        const int it = MODE == 0 ? (it0 < N_TIN ? it0 : it0 + N_TOUT + N_WM) : it0 + N_TIN;
        if (it < N_TIN) {
            const int kt = it & 15, et = it >> 4;
            transpose_tile(p.w_in, DIN, DIN, p.norm_gain, p.w.WinT, kt * 64, et * 128, (float*)smem, tid);
        } else if (it < N_TIN + N_TOUT) {
            const int t = it - N_TIN, kt = t & 15, et = t >> 4;
            transpose_tile(p.w_out, DM, DM, nullptr, p.w.WoutT, kt * 64, et * 128, (float*)smem, tid);
        } else if (it < N_TIN + N_TOUT + N_WM) {
            const int t = it - N_TIN - N_TOUT;
#pragma unroll
            for (int q = 0; q < 4; ++q) {
                const int e = t * 2048 + q * 512 + tid, i = (e >> 7) & 127, j = e & 127;
                const float v = ((j >> 6) <= (i >> 6)) ? p.sgu_w[e] : 0.f;
                p.w.Wm[e] = f2bf(v);
            }
        } else {
            const int row0 = (it - N_TIN - N_TOUT - N_WM) * 32 + wv * 4;
            f32x4 v[4][4];
#pragma unroll
            for (int r = 0; r < 4; ++r)
#pragma unroll
                for (int i = 0; i < 4; ++i) v[r][i] = __builtin_nontemporal_load((const f32x4*)(p.x + (size_t)(row0 + r) * DM + i * 256 + lane * 4));
#pragma unroll
            for (int r = 0; r < 4; ++r) {
                float s = 0.f;
#pragma unroll
                for (int i = 0; i < 4; ++i) s += v[r][i][0] * v[r][i][0] + v[r][i][1] * v[r][i][1] + v[r][i][2] * v[r][i][2] + v[r][i][3] * v[r][i][3];
                s = wave_sum(s);
                if (lane == 0) p.w.rinv[row0 + r] = rsqrtf(s * (1.0f / DM) + EPS);
#pragma unroll
                for (int i = 0; i < 4; ++i) {
                    u32x2 o; o.x = pack_bf2(v[r][i][0], v[r][i][1]); o.y = pack_bf2(v[r][i][2], v[r][i][3]);
                    *(u32x2*)(p.w.xb + (size_t)(row0 + r) * DM + i * 256 + lane * 4) = o;
                }
            }
        }
    }
}

__device__ __forceinline__ float quad_sum(float v) { v += __shfl_xor(v, 16); v += __shfl_xor(v, 32); return v; }

__device__ __forceinline__ void p1_unit(const Params& p, int tb, int ct, char* smem, int tid, int st0 = 0, int pre = 0, int ntb = -1, int nct = 0) {
    asm volatile("" : "+v"(tid));
    const int wv = tid >> 6, lane = tid & 63, wm = wv >> 2, wn = wv & 3, fr = lane & 15, fq = lane >> 4;
    float* st = (float*)(smem + ST_OFF);
    float rr[4];
#pragma unroll
    for (int ni = 0; ni < 4; ++ni) rr[ni] = p.w.rinv[tb * 256 + wn * 64 + ni * 16 + fr];
    f32x4 acc[4][4];
    gemm_ring(p.w.WinT + (size_t)ct * 128 * DM, p.w.xb + (size_t)tb * 256 * DM, smem, acc, tid, st0, pre,
              ntb >= 0 ? p.w.WinT + (size_t)nct * 128 * DM : nullptr, ntb >= 0 ? p.w.xb + (size_t)ntb * 256 * DM : nullptr);
    u32x2 ov[4][4];
    bf16_t* dtile = nullptr;
    if (ct >= 4 && ct < 8) {
#pragma unroll
        for (int ni = 0; ni < 4; ++ni) {
            float s1 = 0.f, s2 = 0.f;
#pragma unroll
            for (int mi = 0; mi < 4; ++mi)
#pragma unroll
                for (int i = 0; i < 4; ++i) { const float gvv = gelu_tanh(acc[mi][ni][i] * rr[ni]); acc[mi][ni][i] = gvv; s1 += gvv; s2 += gvv * gvv; }
            s1 = quad_sum(s1); s2 = quad_sum(s2);
            if (fq == 0) { const int tl = wn * 64 + ni * 16 + fr; st[(tl * 2 + wm) * 2 + 0] = s1; st[(tl * 2 + wm) * 2 + 1] = s2; }
            __builtin_amdgcn_sched_barrier(0);
        }
        __syncthreads();
#pragma unroll
        for (int ni = 0; ni < 4; ++ni) {
            const int tl = wn * 64 + ni * 16 + fr;
            const f32x4 sv = *(const f32x4*)(st + tl * 4);
            const float mu = (sv[0] + sv[2]) * (1.0f / 128.0f);
            const float var = (sv[1] + sv[3]) * (1.0f / 128.0f) - mu * mu;
            const float rs = rsqrtf(fmaxf(var, 0.f) + EPS);
#pragma unroll
            for (int mi = 0; mi < 4; ++mi) {
                const f32x4 gn = *(const f32x4*)(p.sgu_ng + (ct - 4) * 128 + wm * 64 + mi * 16 + fq * 4);
                ov[mi][ni].x = pack_bf2((acc[mi][ni][0] - mu) * rs * gn[0], (acc[mi][ni][1] - mu) * rs * gn[1]);
                ov[mi][ni].y = pack_bf2((acc[mi][ni][2] - mu) * rs * gn[2], (acc[mi][ni][3] - mu) * rs * gn[3]);
            }
            __builtin_amdgcn_sched_barrier(0);
        }
        dtile = p.w.vn + (size_t)tb * 256 * 512 + (ct - 4) * 128;
    } else {
#pragma unroll
        for (int ni = 0; ni < 4; ++ni) {
            const int tok = tb * 256 + wn * 64 + ni * 16 + fr;
            const float r = rr[ni];
            f32x4 v[4];
#pragma unroll
            for (int mi = 0; mi < 4; ++mi) v[mi] = acc[mi][ni] * r;
            if (ct < 4) {
#pragma unroll
                for (int mi = 0; mi < 4; ++mi) { ov[mi][ni].x = pack_bf2(gelu_tanh(v[mi][0]), gelu_tanh(v[mi][1])); ov[mi][ni].y = pack_bf2(gelu_tanh(v[mi][2]), gelu_tanh(v[mi][3])); }
            } else if (ct < 12 || (ct >= 17 && ct < 21)) {
#pragma unroll
                for (int mi = 0; mi < 4; ++mi) { ov[mi][ni].x = pack_bf2(silu_f(v[mi][0]), silu_f(v[mi][1])); ov[mi][ni].y = pack_bf2(silu_f(v[mi][2]), silu_f(v[mi][3])); }
            } else if (ct < 16 || (ct == 16 && wm == 0)) {
                float ss = 0.f;
#pragma unroll
                for (int mi = 0; mi < 4; ++mi) ss += v[mi][0] * v[mi][0] + v[mi][1] * v[mi][1] + v[mi][2] * v[mi][2] + v[mi][3] * v[mi][3];
                ss = quad_sum(ss);
                const bool isq = ct < 16;
                const float sc = rsqrtf(ss * (1.0f / 64.0f) + EPS) * (isq ? (0.125f * 1.4426950408889634f) : 1.0f);
                const float* gain = isq ? p.qg : p.kg;
#pragma unroll
                for (int mi = 0; mi < 4; ++mi) {
                    const int d = mi * 16 + fq * 4;
                    const f32x4 gv = *(const f32x4*)(gain + d);
                    u32x2 o; o.x = pack_bf2(v[mi][0] * sc * gv[0], v[mi][1] * sc * gv[1]); o.y = pack_bf2(v[mi][2] * sc * gv[2], v[mi][3] * sc * gv[3]);
                    if (isq) ov[mi][ni] = o; else *(u32x2*)(p.w.kn + (size_t)tok * 64 + d) = o;
                }
            } else if (ct == 16) {
                const int b = tok >> 11, pos = tok & 2047;
#pragma unroll
                for (int mi = 0; mi < 4; ++mi)
#pragma unroll
                    for (int i = 0; i < 4; ++i) p.w.vt[((size_t)b * 64 + mi * 16 + fq * 4 + i) * SEQ + vt_pos(pos)] = f2bf(v[mi][i]);
            } else if (ct < 25) {
#pragma unroll
                for (int mi = 0; mi < 4; ++mi) { ov[mi][ni].x = pack_bf2(v[mi][0], v[mi][1]); ov[mi][ni].y = pack_bf2(v[mi][2], v[mi][3]); }
            } else if (wm == 0) {
                float s1 = 0.f;
#pragma unroll
                for (int mi = 0; mi < 4; ++mi) s1 += v[mi][0] + v[mi][1] + v[mi][2] + v[mi][3];
                s1 = quad_sum(s1);
                const float mu = s1 * (1.0f / 64.0f);
                float s2 = 0.f;
#pragma unroll
                for (int mi = 0; mi < 4; ++mi) { v[mi] = v[mi] - mu; s2 += v[mi][0] * v[mi][0] + v[mi][1] * v[mi][1] + v[mi][2] * v[mi][2] + v[mi][3] * v[mi][3]; }
                s2 = quad_sum(s2);
                const float rs = rsqrtf(s2 * (1.0f / 64.0f) + EPS);
#pragma unroll
                for (int mi = 0; mi < 4; ++mi) {
                    const int d = mi * 16 + fq * 4;
                    const f32x4 gv = *(const f32x4*)(p.ikg + d);
                    u32x2 o; o.x = pack_bf2(v[mi][0] * rs * gv[0], v[mi][1] * rs * gv[1]); o.y = pack_bf2(v[mi][2] * rs * gv[2], v[mi][3] * rs * gv[3]);
                    *(u32x2*)(p.w.kin + (size_t)tok * 64 + d) = o;
                }
            } else {
                if (fq < 2) *(f32x4*)(p.w.wi + (size_t)tok * 8 + fq * 4) = v[0] * 0.04419417382415922f;
            }
            __builtin_amdgcn_sched_barrier(0);
        }
        if (ct < 4) dtile = p.w.gu + (size_t)tb * 256 * 512 + ct * 128;
        else if (ct < 12) dtile = p.w.gza + (size_t)tb * 256 * 512 + (ct - 8) * 128;
        else if (ct < 16) dtile = p.w.qn + (size_t)tb * 256 * 512 + (ct - 12) * 128;
        else if (ct >= 17 && ct < 21) dtile = p.w.gz + (size_t)tb * 256 * 512 + (ct - 17) * 128;
        else if (ct >= 21 && ct < 25) dtile = p.w.qi + (size_t)tb * 256 * 512 + (ct - 21) * 128;
    }
    if (dtile) {
        bf16_t* img = (bf16_t*)(smem + st0 * RING_STAGE);
        __syncthreads();
#pragma unroll
        for (int hf = 0; hf < 2; ++hf) {
            if ((wn >> 1) == hf) {
#pragma unroll
                for (int ni = 0; ni < 4; ++ni)
#pragma unroll
                    for (int mi = 0; mi < 4; ++mi) *(u32x2*)(img + ((wn & 1) * 64 + ni * 16 + fr) * 136 + wm * 64 + mi * 16 + fq * 4) = ov[mi][ni];
            }
            __syncthreads();
#pragma unroll
            for (int ps = 0; ps < 4; ++ps) {
                const int row = ps * 32 + (tid >> 4), ck = (tid & 15) * 8;
                const u32x4 t = *(const u32x4*)(img + row * 136 + ck);
                *(u32x4*)(dtile + (size_t)(hf * 128 + row) * 512 + ck) = t;
            }
            if (hf == 0) __syncthreads();
        }
    }
}

__device__ __forceinline__ void p1_unit256(const Params& p, int tb, int d, char* smem, int tid, bool pre, int ntb, int nd, int nstb, int nsct) {
    f32x4 acc[8][4];
    gemm_ring256(p.w.WinT + (size_t)d * 256 * DM, p.w.xb + (size_t)tb * 256 * DM, smem, acc, tid, pre);
    asm volatile("" : "+v"(tid));
    const int wv = tid >> 6, lane = tid & 63, wm = wv >> 2, wn = wv & 3, fr = lane & 15, fq = lane >> 4;
    const int ct = 2 * d + wm;
    float rr[4];
#pragma unroll
    for (int ni = 0; ni < 4; ++ni) rr[ni] = p.w.rinv[tb * 256 + wn * 64 + ni * 16 + fr];
    __syncthreads();
    if (ntb >= 0) g2_prefetch0(p.w.WinT + (size_t)nd * 256 * DM, p.w.xb + (size_t)ntb * 256 * DM, smem, tid);
    else if (nstb >= 0) g1_prefetch0(p.w.WinT + (size_t)nsct * 128 * DM, p.w.xb + (size_t)nstb * 256 * DM, smem, tid);
    bf16_t* dbase = ct < 4 ? p.w.gu + ct * 128 : ct < 8 ? p.w.vn + (ct - 4) * 128 : ct < 12 ? p.w.gza + (ct - 8) * 128 : ct < 16 ? p.w.qn + (ct - 12) * 128
                  : ct < 21 ? p.w.gz + (ct - 17) * 128 : p.w.qi + (ct - 21) * 128;
    bf16_t* img = (bf16_t*)(smem + 65536 + wv * 8704);
#pragma unroll
    for (int hf = 0; hf < 2; ++hf) {
#pragma unroll
    for (int n2 = 0; n2 < 2; ++n2) {
        const int ni = hf * 2 + n2;
        const int tok = tb * 256 + wn * 64 + ni * 16 + fr;
        const float r = rr[ni];
        bf16_t* dst = img + (n2 * 16 + fr) * 136 + fq * 4;
        f32x4 v[8];
#pragma unroll
        for (int mi = 0; mi < 8; ++mi) v[mi] = acc[mi][ni] * r;
        if (ct < 4) {
#pragma unroll
            for (int mi = 0; mi < 8; ++mi) { u32x2 o; o.x = pack_bf2(gelu_tanh(v[mi][0]), gelu_tanh(v[mi][1])); o.y = pack_bf2(gelu_tanh(v[mi][2]), gelu_tanh(v[mi][3])); *(u32x2*)(dst + mi * 16) = o; }
        } else if (ct < 8) {
            float s1 = 0.f, s2 = 0.f;
#pragma unroll
            for (int mi = 0; mi < 8; ++mi)
#pragma unroll
                for (int i = 0; i < 4; ++i) { const float gvv = gelu_tanh(v[mi][i]); v[mi][i] = gvv; s1 += gvv; s2 += gvv * gvv; }
            s1 = quad_sum(s1); s2 = quad_sum(s2);
            const float mu = s1 * (1.0f / 128.0f);
            const float rs = rsqrtf(fmaxf(s2 * (1.0f / 128.0f) - mu * mu, 0.f) + EPS);
#pragma unroll
            for (int mi = 0; mi < 8; ++mi) {
                const f32x4 gn = *(const f32x4*)(p.sgu_ng + (ct - 4) * 128 + mi * 16 + fq * 4);
                u32x2 o; o.x = pack_bf2((v[mi][0] - mu) * rs * gn[0], (v[mi][1] - mu) * rs * gn[1]); o.y = pack_bf2((v[mi][2] - mu) * rs * gn[2], (v[mi][3] - mu) * rs * gn[3]);
                *(u32x2*)(dst + mi * 16) = o;
            }
        } else if (ct < 12 || (ct >= 17 && ct < 21)) {
#pragma unroll
            for (int mi = 0; mi < 8; ++mi) { u32x2 o; o.x = pack_bf2(silu_f(v[mi][0]), silu_f(v[mi][1])); o.y = pack_bf2(silu_f(v[mi][2]), silu_f(v[mi][3])); *(u32x2*)(dst + mi * 16) = o; }
        } else if (ct < 16) {
#pragma unroll
            for (int hh = 0; hh < 2; ++hh) {
                float ss = 0.f;
#pragma unroll
                for (int m4 = 0; m4 < 4; ++m4) { const f32x4 t = v[hh * 4 + m4]; ss += t[0] * t[0] + t[1] * t[1] + t[2] * t[2] + t[3] * t[3]; }
                ss = quad_sum(ss);
                const float sc = rsqrtf(ss * (1.0f / 64.0f) + EPS) * (0.125f * 1.4426950408889634f);
#pragma unroll
                for (int m4 = 0; m4 < 4; ++m4) {
                    const f32x4 gv = *(const f32x4*)(p.qg + m4 * 16 + fq * 4); const f32x4 t = v[hh * 4 + m4];
                    u32x2 o; o.x = pack_bf2(t[0] * sc * gv[0], t[1] * sc * gv[1]); o.y = pack_bf2(t[2] * sc * gv[2], t[3] * sc * gv[3]);
                    *(u32x2*)(dst + (hh * 4 + m4) * 16) = o;
                }
            }
        } else if (ct == 16) {
            float ss = 0.f;
#pragma unroll
            for (int m4 = 0; m4 < 4; ++m4) { const f32x4 t = v[m4]; ss += t[0] * t[0] + t[1] * t[1] + t[2] * t[2] + t[3] * t[3]; }
            ss = quad_sum(ss);
            const float sc = rsqrtf(ss * (1.0f / 64.0f) + EPS);
#pragma unroll
            for (int m4 = 0; m4 < 4; ++m4) {
                const f32x4 gv = *(const f32x4*)(p.kg + m4 * 16 + fq * 4); const f32x4 t = v[m4];
                u32x2 o; o.x = pack_bf2(t[0] * sc * gv[0], t[1] * sc * gv[1]); o.y = pack_bf2(t[2] * sc * gv[2], t[3] * sc * gv[3]);
                *(u32x2*)(p.w.kn + (size_t)tok * 64 + m4 * 16 + fq * 4) = o;
            }
            const int b = tok >> 11, pos = tok & 2047;
#pragma unroll
            for (int m4 = 0; m4 < 4; ++m4)
#pragma unroll
                for (int i = 0; i < 4; ++i) p.w.vt[((size_t)b * 64 + m4 * 16 + fq * 4 + i) * SEQ + vt_pos(pos)] = f2bf(v[4 + m4][i]);
        } else {
#pragma unroll
            for (int mi = 0; mi < 8; ++mi) { u32x2 o; o.x = pack_bf2(v[mi][0], v[mi][1]); o.y = pack_bf2(v[mi][2], v[mi][3]); *(u32x2*)(dst + mi * 16) = o; }
        }
        __builtin_amdgcn_sched_barrier(0);
    }
    if (ct != 16) {
        bf16_t* grow = dbase + (size_t)(tb * 256 + wn * 64 + hf * 32) * 512;
#pragma unroll
        for (int ps = 0; ps < 8; ++ps) {
            const int row = ps * 4 + (lane >> 4), ck = (lane & 15) * 8;
            const u32x4 t = *(const u32x4*)(img + row * 136 + ck);
            *(u32x4*)(grow + (size_t)row * 512 + ck) = t;
        }
    }
    }
}

__device__ __forceinline__ void phase1(const Params& p, char* smem, int tid) {
    const int x = blockIdx.x & 7, li = blockIdx.x >> 3;
    const bool xaw = (opaque_grid() == 256);
    const int jlim = xaw ? 96 : 768, jst = xaw ? 32 : (int)gridDim.x;
    bool pre = false;
    for (int j = xaw ? li : (int)blockIdx.x; j < jlim; j += jst) {
        const int tb = xaw ? x + 8 * (4 * (j / 48) + (j & 3)) : j / 12, d = xaw ? (j % 48) / 4 : j % 12;
        const int jn = j + jst;
        const int ntb = jn < jlim ? (xaw ? x + 8 * (4 * (jn / 48) + (jn & 3)) : jn / 12) : -1, nd = xaw ? (jn % 48) / 4 : jn % 12;
        const int nstb = (xaw && ntb < 0 && li < 16) ? x + 8 * (li >> 1) : -1;
        p1_unit256(p, tb, d, smem, tid, pre, ntb, nd, nstb, 24 + (li & 1));
        pre = true;
    }
    for (int u = xaw ? (li < 16 ? li : 128) : (int)blockIdx.x; u < (xaw ? 16 : 128); u += xaw ? 128 : (int)gridDim.x)
        p1_unit(p, xaw ? x + 8 * (u >> 1) : u >> 1, 24 + (u & 1), smem, tid, 0, xaw ? 2 : 0);
    if (xaw) { if (li >= 16) phase0<1>(p, smem, tid, x * 16 + (li - 16), 128); }
    else phase0<1>(p, smem, tid, (int)blockIdx.x, (int)gridDim.x);
}

#define VNT_ROW 136
struct SguOps { u32x4 r[4]; bf16x8 bw[4][2]; u32x2 guv[2][4], zv[2][4]; float bi[2]; };
__device__ __forceinline__ void sgu_load(const Params& p, int nb, int g, int tid, SguOps& o) {
    const int wv = tid >> 6, lane = tid & 63, wm = wv >> 2, wn = wv & 3, fr = lane & 15, fq = lane >> 4;
    const int j = tid >> 2, c0 = (tid & 3) * 32;
    {
        const bf16_t* src = p.w.vn + (size_t)(nb * 128 + j) * 512 + g * 128 + c0;
#pragma unroll
        for (int q = 0; q < 4; ++q) o.r[q] = *(const u32x4*)(src + q * 8);
    }
    const bf16_t* Wg = p.w.Wm + (size_t)g * 128 * 128;
#pragma unroll
    for (int ks = 0; ks < 4; ++ks)
#pragma unroll
        for (int i = 0; i < 2; ++i) o.bw[ks][i] = *(const bf16x8*)(Wg + (size_t)(wn * 32 + i * 16 + fr) * 128 + ks * 32 + fq * 8);
#pragma unroll
    for (int ni = 0; ni < 2; ++ni) {
        const int tl = wn * 32 + ni * 16 + fr;
        o.bi[ni] = p.sgu_b[g * 128 + tl];
#pragma unroll
        for (int mi = 0; mi < 4; ++mi) {
            const size_t off = (size_t)(nb * 128 + tl) * 512 + g * 128 + wm * 64 + mi * 16 + fq * 4;
            o.guv[ni][mi] = *(const u32x2*)(p.w.gu + off);
            o.zv[ni][mi] = *(const u32x2*)(p.w.gza + off);
        }
    }
}
template <bool NEXT>
__device__ __forceinline__ void sgu_compute(const Params& p, int nb, int g, char* smem, int tid, SguOps& o, int nnb, int ng, SguOps& nx) {
    const int wv = tid >> 6, lane = tid & 63, wm = wv >> 2, wn = wv & 3, fr = lane & 15, fq = lane >> 4;
    bf16_t* vnT = (bf16_t*)smem;
    float* st = (float*)(smem + 36864);
    const int j = tid >> 2, c0 = (tid & 3) * 32;
    __syncthreads();
#pragma unroll
    for (int q = 0; q < 4; ++q) {
        const unsigned wds[4] = {o.r[q].x, o.r[q].y, o.r[q].z, o.r[q].w};
#pragma unroll
        for (int e = 0; e < 4; ++e) {
            vnT[(c0 + q * 8 + 2 * e) * VNT_ROW + j] = (bf16_t)(wds[e] & 0xffffu);
            vnT[(c0 + q * 8 + 2 * e + 1) * VNT_ROW + j] = (bf16_t)(wds[e] >> 16);
        }
    }
    __syncthreads();
    if (NEXT) sgu_load(p, nnb, ng, tid, nx);
    f32x4 gnv[4];
#pragma unroll
    for (int mi = 0; mi < 4; ++mi) gnv[mi] = *(const f32x4*)(p.bng + g * 128 + wm * 64 + mi * 16 + fq * 4);
    f32x4 sacc[4][2];
#pragma unroll
    for (int mi = 0; mi < 4; ++mi) { sacc[mi][0] = (f32x4){0.f, 0.f, 0.f, 0.f}; sacc[mi][1] = (f32x4){0.f, 0.f, 0.f, 0.f}; }
#pragma unroll
    for (int ks = 0; ks < 4; ++ks) {
        bf16x8 a[4];
#pragma unroll
        for (int i = 0; i < 4; ++i) a[i] = *(const bf16x8*)(vnT + (wm * 64 + i * 16 + fr) * VNT_ROW + ks * 32 + fq * 8);
#pragma unroll
        for (int mi = 0; mi < 4; ++mi)
#pragma unroll
            for (int ni = 0; ni < 2; ++ni) sacc[mi][ni] = __builtin_amdgcn_mfma_f32_16x16x32_bf16(a[mi], o.bw[ks][ni], sacc[mi][ni], 0, 0, 0);
    }
#pragma unroll
    for (int ni = 0; ni < 2; ++ni) {
        const int tl = wn * 32 + ni * 16 + fr;
        float s2 = 0.f;
#pragma unroll
        for (int mi = 0; mi < 4; ++mi) {
            const u32x2 gv = o.guv[ni][mi];
            const float y0 = bf_lo(gv.x) * (sacc[mi][ni][0] + o.bi[ni]), y1 = bf_hi(gv.x) * (sacc[mi][ni][1] + o.bi[ni]);
            const float y2 = bf_lo(gv.y) * (sacc[mi][ni][2] + o.bi[ni]), y3 = bf_hi(gv.y) * (sacc[mi][ni][3] + o.bi[ni]);
            sacc[mi][ni] = (f32x4){y0, y1, y2, y3};
            s2 += y0 * y0 + y1 * y1 + y2 * y2 + y3 * y3;
        }
        s2 = quad_sum(s2);
        if (fq == 0) st[tl * 2 + wm] = s2;
    }
    __syncthreads();
#pragma unroll
    for (int ni = 0; ni < 2; ++ni) {
        const int tl = wn * 32 + ni * 16 + fr, tok = nb * 128 + tl;
        const float rs = rsqrtf((st[tl * 2] + st[tl * 2 + 1]) * (1.0f / 128.0f) + EPS);
#pragma unroll
        for (int mi = 0; mi < 4; ++mi) {
            const int ch = g * 128 + wm * 64 + mi * 16 + fq * 4;
            const f32x4 gn = gnv[mi];
            const u32x2 zz = o.zv[ni][mi];
            u32x2 ov;
            ov.x = pack_bf2(sacc[mi][ni][0] * rs * gn[0] * bf_lo(zz.x), sacc[mi][ni][1] * rs * gn[1] * bf_hi(zz.x));
            ov.y = pack_bf2(sacc[mi][ni][2] * rs * gn[2] * bf_lo(zz.y), sacc[mi][ni][3] * rs * gn[3] * bf_hi(zz.y));
            *(u32x2*)(p.w.mixed + (size_t)tok * 1024 + ch) = ov;
        }
    }
}

__device__ __forceinline__ void phase_sgu(const Params& p, char* smem, int tid) {
    asm volatile("" : "+v"(tid));
    const int x = blockIdx.x & 7, li = blockIdx.x >> 3;
    const bool xaw = (opaque_grid() == 256);
    if (xaw) {
        const int it = 2 * li, nb = 2 * (x + 8 * (it >> 3)) + ((it >> 2) & 1), g = it & 3;
        SguOps o0, o1;
        sgu_load(p, nb, g, tid, o0);
        sgu_compute<true>(p, nb, g, smem, tid, o0, nb, g + 1, o1);
        sgu_compute<false>(p, nb, g + 1, smem, tid, o1, 0, 0, o0);
    } else {
        for (int it = (int)blockIdx.x; it < 512; it += (int)gridDim.x) {
            SguOps o0;
            sgu_load(p, it >> 2, it & 3, tid, o0);
            sgu_compute<false>(p, it >> 2, it & 3, smem, tid, o0, 0, 0, o0);
        }
    }
}

#define LOG2E 1.4426950408889634f
__device__ __forceinline__ unsigned mono_key(float f) { const unsigned u = __float_as_uint(f); return u ^ ((unsigned)((int)u >> 31) | 0x80000000u); }
__device__ __forceinline__ int half_sum_i(int v) { v += __shfl_xor(v, 16); v += __shfl_xor(v, 8); v += __shfl_xor(v, 4); v += __shfl_xor(v, 2); v += __shfl_xor(v, 1); return v; }
__device__ __forceinline__ float half_min_f(float v) { v = fminf(v, __shfl_xor(v, 16)); v = fminf(v, __shfl_xor(v, 8)); v = fminf(v, __shfl_xor(v, 4)); v = fminf(v, __shfl_xor(v, 2)); v = fminf(v, __shfl_xor(v, 1)); return v; }

__device__ __forceinline__ void p2_item(const Params& p, int b, int qt, char* smem, int tid) {
    asm volatile("" : "+v"(tid));
    bf16_t* sK = (bf16_t*)smem;
    bf16_t* sV = sK + 2 * 64 * LROW;
    unsigned* maskL = (unsigned*)(smem + 36864);
    float* dnearL = (float*)(smem + 36864 + 8192);
    const int wv = tid >> 6, lane = tid & 63, G = lane >> 5, n = lane & 31;
    const int c = qt >> 1, nsteps = c + 1, ntiles = 2 * nsteps;
    const int tok0 = b * SEQ + qt * 32, pos0 = qt * 32;
    const int srow = tid >> 3, sch = (tid & 7) * 8;
    unsigned* mw_wave = maskL + wv * 256;
    __syncthreads();
    const int ql = n >> 3, h = n & 7;
    bf16x8 qfr[4]; u32x4 rk0, rv0; u32x2 gzp[2][4];
    const bf16_t* ksrc = p.w.kn + ((size_t)b * SEQ + srow) * 64 + sch;
    const bf16_t* vsrc = p.w.vt + ((size_t)b * 64 + srow) * SEQ + sch;
#define P2_PREFETCH() do { \
        const bf16_t* _qs = p.w.qn + (size_t)(tok0 + 4 * wv + ql) * 512 + h * 64 + 8 * G; \
        _Pragma("unroll") for (int _s = 0; _s < 4; ++_s) qfr[_s] = *(const bf16x8*)(_qs + 16 * _s); \
        rk0 = *(const u32x4*)(ksrc); rv0 = *(const u32x4*)(vsrc); } while (0)
    if (nsteps > 4) {
        bf16x8 afr[4];
        {
            const int ql = 2 * ((n >> 2) & 1) + (n >> 4), hd = 4 * ((n >> 3) & 1) + (n & 3);
            const bf16_t* src = p.w.qi + (size_t)(tok0 + 4 * wv + ql) * 512 + hd * 64 + 8 * G;
#pragma unroll
            for (int s = 0; s < 4; ++s) afr[s] = *(const bf16x8*)(src + 16 * s);
        }
        float w[16];
        {
            const float* wsrc = p.w.wi + (size_t)(tok0 + 4 * wv + 2 * G) * 8;
#pragma unroll
            for (int q4 = 0; q4 < 4; ++q4) { const f32x4 t = *(const f32x4*)(wsrc + 4 * q4); w[4 * q4] = t[0]; w[4 * q4 + 1] = t[1]; w[4 * q4 + 2] = t[2]; w[4 * q4 + 3] = t[3]; }
        }
        unsigned kk[128];
#pragma unroll
        for (int i = 0; i < 128; ++i) kk[i] = 0u;
        {
        const bf16_t* kisrc = p.w.kin + ((size_t)b * SEQ + srow) * 64 + sch;
        const bf16_t* kip = kisrc;
        u32x4 r0 = *(const u32x4*)(kisrc);
        *(u32x4*)(sK + srow * LROW + sch) = r0;
        __syncthreads();
#pragma unroll
        for (int st = 0; st < 32; ++st) {
            if (st < nsteps) {
                const bf16_t* buf = sK + (st & 1) * 64 * LROW;
                if (st + 1 < nsteps) {
                    kip += 64 * 64; asm volatile("" : "+v"(kip));
                    r0 = *(const u32x4*)(kip);
                }
                unsigned kq[2][2];
#pragma unroll
                for (int kt = 0; kt < 2; ++kt) {
                    f32x16 D;
#pragma unroll
                    for (int k = 0; k < 16; ++k) D[k] = 0.f;
#pragma unroll
                    for (int s = 0; s < 4; ++s) {
                        const bf16x8 bfr = *(const bf16x8*)(buf + (kt * 32 + n) * LROW + 16 * s + 8 * G);
                        D = __builtin_amdgcn_mfma_f32_32x32x16_bf16(afr[s], bfr, D, 0, 0, 0);
                    }
                    float s0 = 0.f, s1 = 0.f;
#pragma unroll
                    for (int k = 0; k < 8; ++k) {
                        const float r0 = __int_as_float(max(__float_as_int(D[k]), 0)), r1 = __int_as_float(max(__float_as_int(D[8 + k]), 0));
                        s0 = fmaf(w[k], r0, s0); s1 = fmaf(w[8 + k], r1, s1);
                    }
                    unsigned k0v = mono_key(s0), k1v = mono_key(s1);
                    asm volatile("" : "+v"(k0v), "+v"(k1v));
                    kq[kt][0] = k0v; kq[kt][1] = k1v;
                    __builtin_amdgcn_sched_barrier(0);
                }
#pragma unroll
                for (int a = 0; a < 2; ++a) {
                    const auto sw = __builtin_amdgcn_permlane32_swap(kq[0][a], kq[1][a], false, false);
                    kk[a * 32 + st] = sw[0];
                    kk[(2 + a) * 32 + st] = sw[1];
                }
                if (st + 1 < nsteps) {
                    bf16_t* nb = sK + ((st + 1) & 1) * 64 * LROW;
                    *(u32x4*)(nb + srow * LROW + sch) = r0;
                }
                __syncthreads();
            }
        }
        }
        P2_PREFETCH();
        {
#define SEL_COUNT(cand_, cnt_) do { unsigned a0_ = 0u, a1_ = 0u; \
            _Pragma("unroll") for (int g8 = 0; g8 < 4; ++g8) { if (g8 * 8 < nsteps) { \
                unsigned long long bm[8]; \
                asm volatile("v_cmp_ge_u32_e64 %2, %10, %18\n\tv_cmp_ge_u32_e64 %3, %11, %18\n\tv_cmp_ge_u32_e64 %4, %12, %18\n\tv_cmp_ge_u32_e64 %5, %13, %18\n\t" \
                             "v_cmp_ge_u32_e64 %6, %14, %18\n\tv_cmp_ge_u32_e64 %7, %15, %18\n\tv_cmp_ge_u32_e64 %8, %16, %18\n\tv_cmp_ge_u32_e64 %9, %17, %18\n\t" \
                             "v_addc_co_u32_e64 %0, %2, %0, 0, %2\n\tv_addc_co_u32_e64 %1, %3, %1, 0, %3\n\tv_addc_co_u32_e64 %0, %4, %0, 0, %4\n\tv_addc_co_u32_e64 %1, %5, %1, 0, %5\n\t" \
                             "v_addc_co_u32_e64 %0, %6, %0, 0, %6\n\tv_addc_co_u32_e64 %1, %7, %1, 0, %7\n\tv_addc_co_u32_e64 %0, %8, %0, 0, %8\n\tv_addc_co_u32_e64 %1, %9, %1, 0, %9" \
                             : "+v"(a0_), "+v"(a1_), "=&s"(bm[0]), "=&s"(bm[1]), "=&s"(bm[2]), "=&s"(bm[3]), "=&s"(bm[4]), "=&s"(bm[5]), "=&s"(bm[6]), "=&s"(bm[7]) \
                             : "v"(kk[q * 32 + g8 * 8 + 0]), "v"(kk[q * 32 + g8 * 8 + 1]), "v"(kk[q * 32 + g8 * 8 + 2]), "v"(kk[q * 32 + g8 * 8 + 3]), \
                               "v"(kk[q * 32 + g8 * 8 + 4]), "v"(kk[q * 32 + g8 * 8 + 5]), "v"(kk[q * 32 + g8 * 8 + 6]), "v"(kk[q * 32 + g8 * 8 + 7]), "v"(cand_)); } } \
            unsigned s_ = a0_ + a1_; \
            s_ += (unsigned)__builtin_amdgcn_update_dpp(0, (int)s_, 0x111, 0xf, 0xf, true); \
            s_ += (unsigned)__builtin_amdgcn_update_dpp(0, (int)s_, 0x112, 0xf, 0xf, true); \
            s_ += (unsigned)__builtin_amdgcn_update_dpp(0, (int)s_, 0x114, 0xf, 0xf, true); \
            s_ += (unsigned)__builtin_amdgcn_update_dpp(0, (int)s_, 0x118, 0xf, 0xf, true); \
            s_ += (unsigned)__builtin_amdgcn_update_dpp(0, (int)s_, 0x142, 0xa, 0xf, true); \
            s_ += (unsigned)__builtin_amdgcn_update_dpp(0, (int)s_, 0x143, 0xc, 0xf, true); \
            cnt_ = __builtin_amdgcn_readlane((int)s_, 63); } while (0)
#pragma unroll
        for (int q = 0; q < 4; ++q) {
            unsigned lo, hi; int clo, chi, cnt; bool exact = false;
            { const unsigned c0 = 0x80000000u; SEL_COUNT(c0, cnt); }
            const bool pos = cnt >= 256;
            unsigned mx = 0u;
            if (pos) {
#pragma unroll
                for (int g8 = 0; g8 < 4; ++g8) {
                    if (g8 * 8 < nsteps) {
#pragma unroll
                        for (int j = 0; j < 8; ++j) mx = max(mx, kk[q * 32 + g8 * 8 + j]);
                    }
                }
            } else {
#pragma unroll
                for (int g8 = 0; g8 < 4; ++g8) {
                    if (g8 * 8 < nsteps) {
#pragma unroll
                        for (int j = 0; j < 8; ++j) { const unsigned k_ = kk[q * 32 + g8 * 8 + j]; mx = max(mx, k_ & ~(unsigned)((int)k_ >> 31)); }
                    }
                }
            }
            mx = max(mx, (unsigned)__builtin_amdgcn_update_dpp(0, (int)mx, 0x111, 0xf, 0xf, true));
            mx = max(mx, (unsigned)__builtin_amdgcn_update_dpp(0, (int)mx, 0x112, 0xf, 0xf, true));
            mx = max(mx, (unsigned)__builtin_amdgcn_update_dpp(0, (int)mx, 0x114, 0xf, 0xf, true));
            mx = max(mx, (unsigned)__builtin_amdgcn_update_dpp(0, (int)mx, 0x118, 0xf, 0xf, true));
            mx = max(mx, (unsigned)__builtin_amdgcn_update_dpp(0, (int)mx, 0x142, 0xa, 0xf, true));
            mx = max(mx, (unsigned)__builtin_amdgcn_update_dpp(0, (int)mx, 0x143, 0xc, 0xf, true));
            const unsigned e = (unsigned)__builtin_amdgcn_readlane((int)mx, 63) >> 23;
            unsigned ba, bb;
            if (pos) { lo = 0x80000000u; clo = cnt; exact = (cnt == 256); hi = (e >= 0x1ffu) ? 0xffffffffu : (e + 1u) << 23; chi = 0; ba = 0x100u; }
            else     { lo = 0u; clo = 64 * nsteps; hi = (e + 1u) << 23; chi = cnt; ba = 0u; }
            bb = e + 1u;
            for (int tries = 0; tries < 12 && !exact && bb - ba > 1u; ++tries) {
                const unsigned m = pos ? ((tries == 0 && e - 1u > ba) ? e - 1u : bb - 1u) : (ba + bb) >> 1;
                const unsigned cand = m << 23;
                SEL_COUNT(cand, cnt);
                if (cnt >= 256) { ba = m; lo = cand; clo = cnt; exact = (cnt == 256); if (pos) break; }
                else { bb = m; hi = cand; chi = cnt; }
            }
            float wl = (float)clo, wh = (float)chi; int last = 0;
            for (int it = 0; !exact && hi - lo > 1u; ++it) {
                const unsigned width = hi - lo;
                unsigned off = width >> 1;
                if (it < 24) off = (unsigned)((float)width * ((wl - 256.0f) * __builtin_amdgcn_rcpf(wl - wh)));
                off = min(max(off, 1u), width - 1u);
                const unsigned cand = lo + off;
                SEL_COUNT(cand, cnt);
                if (cnt >= 256) { lo = cand; clo = cnt; exact = (cnt == 256); wl = (float)cnt; if (last == 1) wh = 256.0f - (256.0f - wh) * 0.5f; last = 1; }
                else { hi = cand; chi = cnt; wh = (float)cnt; if (last == 2) wl = 256.0f + (wl - 256.0f) * 0.5f; last = 2; }
            }
            const unsigned T = lo;
            unsigned mrow = 0u;
            if (exact) {
#pragma unroll
                for (int g4 = 0; g4 < 8; ++g4) {
                    if (g4 * 4 < nsteps) {
#pragma unroll
                        for (int j = 0; j < 4; ++j) {
                            const int pp = g4 * 4 + j;
                            const unsigned long long sb = __ballot(kk[q * 32 + pp] >= T);
                            asm volatile("s_nop 1\n\tv_writelane_b32 %0, %1, %3\n\tv_writelane_b32 %0, %2, %4" : "+v"(mrow) : "s"((unsigned)sb), "s"((unsigned)(sb >> 32)), "n"(2 * pp), "n"(2 * pp + 1));
                        }
                    }
                }
            } else {
                int cg = 0;
#pragma unroll
                for (int g4 = 0; g4 < 8; ++g4) {
                    if (g4 * 4 < nsteps) {
#pragma unroll
                        for (int j = 0; j < 4; ++j) cg += __builtin_popcountll(__ballot(kk[q * 32 + g4 * 4 + j] > T));
                    }
                }
                const int need = 256 - cg;
                int run = 0;
#pragma unroll
                for (int g4 = 0; g4 < 8; ++g4) {
                    if (g4 * 4 < nsteps) {
#pragma unroll
                        for (int j = 0; j < 4; ++j) {
                            const int pp = g4 * 4 + j;
                            const unsigned key = kk[q * 32 + pp];
                            const bool eq = key == T;
                            const unsigned long long eb = __ballot(eq);
                            const int rank = run + (int)__builtin_amdgcn_mbcnt_hi((unsigned)(eb >> 32), __builtin_amdgcn_mbcnt_lo((unsigned)eb, 0u));
                            run += __builtin_popcountll(eb);
                            const unsigned long long sb = __ballot((key > T) || (eq && rank < need));
                            asm volatile("s_nop 1\n\tv_writelane_b32 %0, %1, %3\n\tv_writelane_b32 %0, %2, %4" : "+v"(mrow) : "s"((unsigned)sb), "s"((unsigned)(sb >> 32)), "n"(2 * pp), "n"(2 * pp + 1));
                        }
                    }
                }
            }
            mw_wave[q * 64 + lane] = mrow;
            const unsigned bits = mrow;
            const int qp = pos0 + 4 * wv + q, wq = qp >> 5, bq = qp & 31;
            const unsigned lo_m = (lane < wq) ? bits : ((lane == wq) ? (bits & (0xffffffffu >> (31 - bq))) : 0u);
            const unsigned hi_m = (lane > wq) ? bits : ((lane == wq) ? (bits & (0xffffffffu << bq)) : 0u);
            float d = 1e9f;
            if (lo_m) d = (float)(qp - (32 * lane + 31 - __clz((int)lo_m)));
            if (hi_m) d = fminf(d, (float)(32 * lane + (__ffs((int)hi_m) - 1) - qp));
            d = fminf(d, __shfl_xor(d, 32)); d = half_min_f(d);
            if (lane == 0) dnearL[wv * 4 + q] = d;
        }
#undef SEL_COUNT
        }
    } else {
        P2_PREFETCH();
        for (int i = lane; i < 256; i += 64) mw_wave[i] = ((i & 63) < ntiles) ? 0xffffffffu : 0u;
        if (lane < 4) dnearL[wv * 4 + lane] = 0.f;
    }
    const float slope2 = exp2f(-(float)(h + 1)) * LOG2E;
    const float qposf = (float)(pos0 + 4 * wv + ql);
    f32x16 o0, o1, ol; float l = 0.f, dn = 0.f;
#pragma unroll
    for (int dt = 0; dt < 2; ++dt)
#pragma unroll
        for (int kq = 0; kq < 4; ++kq) gzp[dt][kq] = *(const u32x2*)(p.w.gz + (size_t)(tok0 + 4 * wv + ql) * 512 + h * 64 + dt * 32 + 8 * kq + 4 * G);
    bf16x8 ones;
#pragma unroll
    for (int k = 0; k < 8; ++k) ones[k] = (short)0x3f80;
    {
    __syncthreads();
    dn = dnearL[wv * 4 + ql];
    *(u32x4*)(sK + srow * LROW + sch) = rk0;
    *(u32x4*)(sV + srow * LROW + sch) = rv0;
    __syncthreads();
#pragma unroll
    for (int k = 0; k < 16; ++k) { o0[k] = 0.f; o1[k] = 0.f; ol[k] = 0.f; }
    l = 0.f;
    for (int st = 0; st < nsteps; ++st) {
        const bf16_t* bK = sK + (st & 1) * 64 * LROW;
        const bf16_t* bV = sV + (st & 1) * 64 * LROW;
        if (st + 1 < nsteps) {
            rk0 = *(const u32x4*)(ksrc + (size_t)(st + 1) * 64 * 64);
            rv0 = *(const u32x4*)(vsrc + (st + 1) * 64);
        }
#pragma unroll
        for (int kt = 0; kt < 2; ++kt) {
            const unsigned mwsh = mw_wave[ql * 64 + 2 * st + kt] >> (4 * G);
            const float kb = (float)(st * 64 + kt * 32 + 4 * G);
            f32x16 D;
            if (st < c) {
                const float e = slope2 * (kb - qposf + dn);
#pragma unroll
                for (int k = 0; k < 16; ++k) D[k] = fmaf(slope2, (float)((k & 3) + 8 * (k >> 2)), e);
            } else {
#pragma unroll
                for (int k = 0; k < 16; ++k) D[k] = -slope2 * (fabsf(qposf - kb - (float)((k & 3) + 8 * (k >> 2))) - dn);
            }
#pragma unroll
            for (int s = 0; s < 4; ++s) {
                const bf16x8 kfr = *(const bf16x8*)(bK + (kt * 32 + n) * LROW + 16 * s + 8 * G);
                D = __builtin_amdgcn_mfma_f32_32x32x16_bf16(kfr, qfr[s], D, 0, 0, 0);
            }
            unsigned pk[8];
#pragma unroll
            for (int k2 = 0; k2 < 8; ++k2) {
                float pe[2];
#pragma unroll
                for (int u = 0; u < 2; ++u) {
                    const int k = 2 * k2 + u, ck = (k & 3) + 8 * (k >> 2);
                    const float e = __builtin_amdgcn_exp2f(D[k]);
                    const int m = __builtin_amdgcn_sbfe((int)mwsh, ck, 1);
                    pe[u] = __uint_as_float(__float_as_uint(e) & (unsigned)m);
                }
                pk[k2] = pack_bf2(pe[0], pe[1]);
            }
            bf16x8 pf[2];
#pragma unroll
            for (int ks = 0; ks < 2; ++ks) {
                u32x4 t; t.x = pk[4 * ks]; t.y = pk[4 * ks + 1]; t.z = pk[4 * ks + 2]; t.w = pk[4 * ks + 3];
                pf[ks] = __builtin_bit_cast(bf16x8, t);
            }
#pragma unroll
            for (int ks = 0; ks < 2; ++ks) {
                const bf16x8 v0 = *(const bf16x8*)(bV + n * LROW + (2 * kt + ks) * 16 + 8 * G);
                const bf16x8 v1 = *(const bf16x8*)(bV + (32 + n) * LROW + (2 * kt + ks) * 16 + 8 * G);
                o0 = __builtin_amdgcn_mfma_f32_32x32x16_bf16(v0, pf[ks], o0, 0, 0, 0);
                o1 = __builtin_amdgcn_mfma_f32_32x32x16_bf16(v1, pf[ks], o1, 0, 0, 0);
                ol = __builtin_amdgcn_mfma_f32_32x32x16_bf16(ones, pf[ks], ol, 0, 0, 0);
            }
        }
        if (st + 1 < nsteps) {
            bf16_t* nK = sK + ((st + 1) & 1) * 64 * LROW; bf16_t* nV = sV + ((st + 1) & 1) * 64 * LROW;
            *(u32x4*)(nK + srow * LROW + sch) = rk0;
            *(u32x4*)(nV + srow * LROW + sch) = rv0;
        }
        __syncthreads();
    }
    }
    l = ol[0];
    const float il = 1.0f / l;
    float ss = 0.f;
#pragma unroll
    for (int k = 0; k < 16; ++k) { o0[k] *= il; o1[k] *= il; ss += o0[k] * o0[k] + o1[k] * o1[k]; }
    ss += __shfl_xor(ss, 32);
    const float rs = rsqrtf(ss * (1.0f / 64.0f) + EPS);
    bf16_t* oimg = (bf16_t*)(smem + 49152) + wv * (4 * 8 * 72);
#pragma unroll
    for (int dt = 0; dt < 2; ++dt)
#pragma unroll
        for (int kq = 0; kq < 4; ++kq) {
            const int d0 = dt * 32 + 8 * kq + 4 * G;
            const f32x4 gn = *(const f32x4*)(p.bng + 512 + h * 64 + d0);
            const u32x2 gzv = gzp[dt][kq];
            const float z0 = __uint_as_float(gzv.x << 16), z1 = __uint_as_float(gzv.x & 0xffff0000u), z2 = __uint_as_float(gzv.y << 16), z3 = __uint_as_float(gzv.y & 0xffff0000u);
            const float y0 = (dt ? o1[4 * kq] : o0[4 * kq]) * rs * gn[0] * z0, y1 = (dt ? o1[4 * kq + 1] : o0[4 * kq + 1]) * rs * gn[1] * z1;
            const float y2 = (dt ? o1[4 * kq + 2] : o0[4 * kq + 2]) * rs * gn[2] * z2, y3 = (dt ? o1[4 * kq + 3] : o0[4 * kq + 3]) * rs * gn[3] * z3;
            u32x2 o; o.x = pack_bf2(y0, y1); o.y = pack_bf2(y2, y3);
            *(u32x2*)(oimg + (ql * 8 + h) * 72 + d0) = o;
        }
#pragma unroll
    for (int q = 0; q < 4; ++q) {
        const u32x4 t = *(const u32x4*)(oimg + (q * 8 + (lane >> 3)) * 72 + (lane & 7) * 8);
        *(u32x4*)(p.w.mixed + (size_t)(tok0 + 4 * wv + q) * 1024 + 512 + lane * 8) = t;
    }
}

__device__ __forceinline__ void phase2(const Params& p, char* smem, int tid) {
    const int Gn = gridDim.x, bi = blockIdx.x;
    for (int rd = 0;; ++rd) {
        const int rank = rd * Gn + ((rd & 1) ? (Gn - 1 - bi) : bi);
        if (rank >= 512) break;
        const int c = 31 - (rank >> 4), j = rank & 15;
        p2_item(p, j >> 1, c * 2 + (j & 1), smem, tid);
    }
}

__device__ __forceinline__ void phase3(const Params& p, char* smem, int tid) {
    const bool xaw = (opaque_grid() == 256);
    for (int r = 0;; ++r) {
        int u;
        if (xaw) { if (r) break; u = ((blockIdx.x & 7) + 8 * (blockIdx.x >> 5)) * 4 + ((blockIdx.x >> 3) & 3); }
        else { u = blockIdx.x + r * gridDim.x; if (u >= 256) break; }
        const int tb = u >> 2, cb = u & 3;
        f32x4 acc[8][4];
        gemm_ring256(p.w.WoutT + (size_t)cb * 256 * DM, p.w.mixed + (size_t)tb * 256 * DM, smem, acc, tid);
        asm volatile("" : "+v"(tid));
        const int wv = tid >> 6, lane = tid & 63, wm = wv >> 2, wn = wv & 3, fr = lane & 15, fq = lane >> 4;
        float* img = (float*)(smem + wv * 16896);
        __syncthreads();
        const size_t gbase = (size_t)(tb * 256 + wn * 64) * DM + cb * 256 + wm * 128 + (lane & 31) * 4;
#pragma unroll
        for (int hf = 0; hf < 2; ++hf) {
#pragma unroll
            for (int n2 = 0; n2 < 2; ++n2)
#pragma unroll
                for (int mi = 0; mi < 8; ++mi) *(f32x4*)(img + (n2 * 16 + fr) * 132 + mi * 16 + fq * 4) = acc[mi][hf * 2 + n2];
#pragma unroll
            for (int bt = 0; bt < 2; ++bt) {
                f32x4 xv[8];
#pragma unroll
                for (int ps = 0; ps < 8; ++ps) {
                    const int row = (bt * 8 + ps) * 2 + (lane >> 5);
                    xv[ps] = __builtin_nontemporal_load((const f32x4*)(p.x + gbase + (size_t)(hf * 32 + row) * DM));
                }
#pragma unroll
                for (int ps = 0; ps < 8; ++ps) {
                    const int row = (bt * 8 + ps) * 2 + (lane >> 5);
                    const f32x4 t = *(const f32x4*)(img + row * 132 + (lane & 31) * 4);
                    __builtin_nontemporal_store(xv[ps] + t, (f32x4*)(p.out + gbase + (size_t)(hf * 32 + row) * DM));
                }
            }
        }
    }
}

#define XB_TMO      128
#define XB_XCNT(j)  (256  + 64 * (j))
#define XB_XSUB(j)  (1280 + 64 * (j))
#define XB_XGEN(j)  (2304 + 64 * (j))
#define XB_TOP      3328
#define XB_TOPGEN   3392
#define XCD_BAR_WORDS 3456
#define XB_SPIN_CAP (1u << 18)
#define XLAS __attribute__((address_space(3)))
__device__ __forceinline__ unsigned xb_ld(unsigned* p)              { return __hip_atomic_load(p, __ATOMIC_RELAXED, __HIP_MEMORY_SCOPE_AGENT); }
__device__ __forceinline__ unsigned xb_add(unsigned* p, unsigned v) { return __hip_atomic_fetch_add(p, v, __ATOMIC_RELAXED, __HIP_MEMORY_SCOPE_AGENT); }
__device__ __forceinline__ unsigned xb_xcc_id() { return (unsigned)__builtin_amdgcn_s_getreg((3 << 11) | 20) & 0xFu; }
#define XB_SPIN(cond, bar) do { unsigned _sp = 0; while (cond) { __builtin_amdgcn_s_sleep(1); \
    if ((++_sp & 255u) == 0u) { if (xb_ld(&(bar)[XB_TMO])) break; if (_sp > XB_SPIN_CAP) { atomicAdd(&(bar)[XB_TMO], 1u); break; } } } } while (0)
struct XcdBarrier { unsigned* bar; unsigned x; volatile XLAS unsigned* st; };
__device__ __forceinline__ XcdBarrier xcd_barrier_post(unsigned* bar, volatile XLAS unsigned* st) {
    XcdBarrier b; b.bar = bar; b.x = xb_xcc_id(); b.st = st;
    if (threadIdx.x == 0) (void)xb_add(&bar[XB_XCNT(b.x)], 1u);
    return b;
}
__device__ __forceinline__ void xcd_barrier_complete(unsigned* bar, unsigned x, unsigned& nloc, unsigned& nx) {
    const unsigned G = gridDim.x * gridDim.y * gridDim.z;
    unsigned sum, cnt, mine, sp = 0u;
    for (;;) {
        sum = 0u; cnt = 0u; mine = 0u;
#pragma unroll
        for (unsigned j = 0; j < 16; ++j) { const unsigned c = xb_ld(&bar[XB_XCNT(j)]); sum += c; cnt += (c > 0u) ? 1u : 0u; mine = (j == x) ? c : mine; }
        if (sum == G) break;
        __builtin_amdgcn_s_sleep(1);
        if ((++sp & 255u) == 0u) { if (xb_ld(&bar[XB_TMO])) break; if (sp > XB_SPIN_CAP) { atomicAdd(&bar[XB_TMO], 1u); break; } }
    }
    nloc = mine > 0u ? mine : 1u; nx = cnt > 0u ? cnt : 1u;
}
__device__ __forceinline__ void xcd_barrier(const XcdBarrier& b) {
    asm volatile("s_waitcnt vmcnt(0)" ::: "memory");
    __syncthreads();
    int t0 = threadIdx.x; asm volatile("" : "+v"(t0));
    if (t0 == 0) {
        unsigned* bar = b.bar;
        __builtin_amdgcn_s_waitcnt(0);
        unsigned nloc = b.st[0], nx = b.st[1];
        if (nloc == 0u) { xcd_barrier_complete(bar, b.x, nloc, nx); b.st[0] = nloc; b.st[1] = nx; }
        const unsigned old = xb_add(&bar[XB_XSUB(b.x)], 1u);
        const unsigned gen = old / nloc;
        if (old + 1u == (gen + 1u) * nloc) {
            __builtin_amdgcn_fence(__ATOMIC_RELEASE, "agent");
            asm volatile("s_waitcnt vmcnt(0)" ::: "memory");
            const unsigned og = xb_add(&bar[XB_TOP], 1u);
            const unsigned tg = og / nx;
            if (og + 1u == (tg + 1u) * nx) xb_add(&bar[XB_TOPGEN], 1u);
            else XB_SPIN(xb_ld(&bar[XB_TOPGEN]) == tg, bar);
            __builtin_amdgcn_fence(__ATOMIC_ACQUIRE, "agent");
            xb_add(&bar[XB_XGEN(b.x)], 1u);
            asm volatile("s_waitcnt vmcnt(0)" ::: "memory");
        } else {
            XB_SPIN(xb_ld(&bar[XB_XGEN(b.x)]) == gen, bar);
            __builtin_amdgcn_fence(__ATOMIC_ACQUIRE, "agent");
            asm volatile("s_waitcnt vmcnt(0)" ::: "memory");
        }
    }
    __syncthreads();
}

__global__ void __launch_bounds__(NT, 2) mega_kernel(Params p, int mask) {
    __shared__ __attribute__((aligned(16))) char smem[SMEM_BYTES + 16];
    cg::grid_group grid = cg::this_grid();
    int tid = threadIdx.x;
    volatile XLAS unsigned* xst = (volatile XLAS unsigned*)(smem + SMEM_BYTES);
    if (tid < 4) xst[tid] = 0u;
    __syncthreads();
    const XcdBarrier xb = xcd_barrier_post(p.w.bar, xst);
    if (mask) grid.sync();
    phase0<0>(p, smem, tid, (int)blockIdx.x, (int)gridDim.x); xcd_barrier(xb);
    phase1(p, smem, tid);    xcd_barrier(xb);
    phase_sgu(p, smem, tid);
    phase2(p, smem, tid);    xcd_barrier(xb);
    phase3(p, smem, tid);
}

extern "C" void kernel_launch(void* const* d_in, const int* in_sizes, int n_in, void* d_out, int out_size, void* d_ws, size_t ws_size,
                              hipStream_t stream) {
    const float* x = (const float*)d_in[0];
    const float* norm_gain = (const float*)d_in[1];
    const float* w_in = (const float*)d_in[2];
    const float* sgu_ng = (const float*)d_in[3];
    const float* sgu_w = (const float*)d_in[4];
    const float* sgu_b = (const float*)d_in[5];
    const float* qg = (const float*)d_in[6];
    const float* kg = (const float*)d_in[7];
    const float* ikg = (const float*)d_in[8];
    const float* bng = (const float*)d_in[9];
    const float* w_out = (const float*)d_in[10];
    float* out = (float*)d_out;
    WS w = make_ws(d_ws);
    Params p{};
    p.x = x; p.norm_gain = norm_gain; p.w_in = w_in; p.sgu_ng = sgu_ng; p.sgu_w = sgu_w; p.sgu_b = sgu_b;
    p.qg = qg; p.kg = kg; p.ikg = ikg; p.bng = bng; p.w_out = w_out; p.out = out; p.w = w;
    static int grid_blocks = 0;
    if (!grid_blocks) {
        int dev = 0, cus = 0, per_cu = 0;
        (void)hipGetDevice(&dev);
        (void)hipDeviceGetAttribute(&cus, hipDeviceAttributeMultiprocessorCount, dev);
        (void)hipOccupancyMaxActiveBlocksPerMultiprocessor(&per_cu, mega_kernel, NT, 0);
        if (per_cu > 1) per_cu = 1;
        if (per_cu < 1) per_cu = 1;
        grid_blocks = cus * per_cu;
    }
    int mask1 = 0;
    (void)hipMemsetAsync(w.bar, 0, (size_t)4096 * 4, stream);
    {
        void* args[] = {&p, &mask1};
        hipError_t e = hipLaunchCooperativeKernel((void*)mega_kernel, dim3(grid_blocks), dim3(NT), args, 0, stream);
        if (e != hipSuccess) fprintf(stderr, "cooperative launch failed: %s (grid %d)\n", hipGetErrorString(e), grid_blocks);
    }
}
```
